# Optimizing an MI355X kernel written in HIP

```python
import math
import jax, jax.numpy as jnp
from jax import lax
import numpy as np

D_MODEL = 2048
BATCH = 2
SEQ = 4096
DEPTH = 4
DEC_BATCH = 32
DEC_SEQ = 8
PAST_LEN = 16384
PAGE_SIZE = 128

N_A_LAYERS = DEPTH // 2
N_B_LAYERS = DEPTH - N_A_LAYERS
HGRN_HEADS = 16
HGRN_DK = D_MODEL // HGRN_HEADS
HGRN_DV = D_MODEL // HGRN_HEADS
HGRN_CHUNK = 16
ATTN_HEAD_DIM = 64
ATTN_Q_HEADS = D_MODEL // ATTN_HEAD_DIM
ATTN_KV_HEADS = 8
GQA_GROUP = ATTN_Q_HEADS // ATTN_KV_HEADS
WINDOW = 128
ROPE_THETA = 10000.0
ATTN_SCALE = ATTN_HEAD_DIM ** -0.5
D_FF = -(-8 * D_MODEL // (3 * 256)) * 256
RMS_EPS = 1e-6
MASK_VALUE = -1e30
MIN_FORGET = 1e-30

kernel_name = 'hybrid_hgrn2_yoco_swa_sink_step'


def rms_norm(x, g):
    xf = x.astype(jnp.float32)
    y = xf * lax.rsqrt(jnp.mean(xf * xf, axis=-1, keepdims=True) + RMS_EPS)
    return (y * g.astype(jnp.float32)).astype(x.dtype)


def rope(x, pos):
    half = x.shape[-1] // 2
    inv = ROPE_THETA ** (-jnp.arange(half, dtype=jnp.float32) / half)
    ang = pos.astype(jnp.float32)[:, None] * inv[None, :]
    cos = jnp.cos(ang)[:, None, :]
    sin = jnp.sin(ang)[:, None, :]
    xf = x.astype(jnp.float32)
    x1, x2 = xf[..., :half], xf[..., half:]
    return jnp.concatenate([x1 * cos - x2 * sin, x2 * cos + x1 * sin], axis=-1).astype(x.dtype)


def swiglu(h, w_gate, w_up, w_down):
    return (jax.nn.silu(h @ w_gate) * (h @ w_up)) @ w_down


def gla_chunked(q, k, log_f, v, s0, chunk):
    B, T, H, DK = q.shape
    n = T // chunk

    def to_chunks(a):
        return jnp.moveaxis(a.reshape(B, n, chunk, H, a.shape[-1]), 1, 0)

    causal = jnp.tril(jnp.ones((chunk, chunk), dtype=bool))[None, :, :, None, None]

    def step(S, inp):
        qc, kc, gc, vc = inp
        G = jnp.cumsum(gc, axis=1)
        diff = G[:, :, None] - G[:, None, :]
        decay = jnp.where(causal, jnp.exp(jnp.minimum(diff, 0.0)), 0.0)
        A = jnp.einsum('bihd,bjhd,bijhd->bhij', qc, kc, decay)
        o_intra = jnp.einsum('bhij,bjhv->bihv', A, vc)
        o_inter = jnp.einsum('bihd,bhdv->bihv', qc * jnp.exp(G), S)
        G_last = G[:, -1]
        k_dec = kc * jnp.exp(G_last[:, None] - G)
        S_new = jnp.exp(G_last)[..., None] * S + jnp.einsum('bjhd,bjhv->bhdv', k_dec, vc)
        return S_new, o_intra + o_inter

    s_fin, o = lax.scan(step, s0, (to_chunks(q), to_chunks(k), to_chunks(log_f), to_chunks(v)))
    o = jnp.moveaxis(o, 0, 1).reshape(B, T, H, v.shape[-1])
    return o, s_fin


def hgrn2_mixer(h, w_q, w_f, w_i, w_g, lb, g_o, w_o, s0, chunk):
    B, T, _ = h.shape
    shp = (B, T, HGRN_HEADS, HGRN_DK)
    q = jax.nn.silu(h @ w_q).reshape(shp).astype(jnp.float32) * (HGRN_DK ** -0.5)
    z = (h @ w_f).reshape(shp).astype(jnp.float32)
    lb = lb.reshape(HGRN_HEADS, HGRN_DK)
    f = lb + (1.0 - lb) * jax.nn.sigmoid(z)
    log_f = jnp.log(jnp.maximum(f, MIN_FORGET))
    k = (1.0 - lb) * jax.nn.sigmoid(-z)
    v = (h @ w_i).reshape(B, T, HGRN_HEADS, HGRN_DV).astype(jnp.float32)
    o, s_fin = gla_chunked(q, k, log_f, v, s0.astype(jnp.float32), chunk)
    o = rms_norm(o, g_o).reshape(B, T, D_MODEL).astype(h.dtype)
    o = o * jax.nn.silu(h @ w_g)
    return o @ w_o, s_fin


def sink_probs(s, mask, sinks):
    s = jnp.where(mask, s, MASK_VALUE)
    sk = sinks.astype(jnp.float32).reshape(ATTN_KV_HEADS, GQA_GROUP, 1, 1)
    m = jnp.maximum(jnp.max(s, axis=-1, keepdims=True), sk)
    p = jnp.where(mask, jnp.exp(s - m), 0.0)
    return p / (jnp.sum(p, axis=-1, keepdims=True) + jnp.exp(sk - m))


def swa_prompt(q, k, v, sinks):
    B, T = q.shape[:2]
    n = T // WINDOW
    qb = q.reshape(B, n, WINDOW, ATTN_KV_HEADS, GQA_GROUP, ATTN_HEAD_DIM)
    pad = ((0, 0), (WINDOW, 0), (0, 0), (0, 0))
    kb = jnp.pad(k, pad).reshape(B, n + 1, WINDOW, ATTN_KV_HEADS, ATTN_HEAD_DIM)
    vb = jnp.pad(v, pad).reshape(B, n + 1, WINDOW, ATTN_KV_HEADS, ATTN_HEAD_DIM)
    kband = jnp.concatenate([kb[:, :-1], kb[:, 1:]], axis=2)
    vband = jnp.concatenate([vb[:, :-1], vb[:, 1:]], axis=2)
    s = jnp.einsum('bnqhgd,bnkhd->bnhgqk', qb, kband).astype(jnp.float32) * ATTN_SCALE
    i = jnp.arange(WINDOW)[:, None]
    j = jnp.arange(2 * WINDOW)[None, :]
    rel = WINDOW + i - j
    blk = jnp.arange(n)[:, None, None]
    mask = (rel >= 0) & (rel < WINDOW) & ((blk - 1) * WINDOW + j >= 0)
    p = sink_probs(s, mask[None, :, None, None], sinks)
    o = jnp.einsum('bnhgqk,bnkhd->bnqhgd', p.astype(v.dtype), vband)
    return o.reshape(B, T, ATTN_Q_HEADS * ATTN_HEAD_DIM)


def swa_sample(q, k_all, v_all, sinks):
    B, S = q.shape[:2]
    L = k_all.shape[1]
    qg = q.reshape(B, S, ATTN_KV_HEADS, GQA_GROUP, ATTN_HEAD_DIM)
    s = jnp.einsum('bqhgd,bkhd->bhgqk', qg, k_all).astype(jnp.float32) * ATTN_SCALE
    rel = (L - S) + jnp.arange(S)[:, None] - jnp.arange(L)[None, :]
    mask = (rel >= 0) & (rel < WINDOW)
    p = sink_probs(s, mask, sinks)
    o = jnp.einsum('bhgqk,bkhd->bqhgd', p.astype(v_all.dtype), v_all)
    return o.reshape(B, S, ATTN_Q_HEADS * ATTN_HEAD_DIM)


def trunk(x, pos, s0, chunk, past_k, past_v,
          hgrn_norm, hgrn_wq, hgrn_wf, hgrn_wi, hgrn_wg, lower_bounds, hgrn_onorm, hgrn_wo,
          kv_norm, w_k, w_v, k_norm,
          attn_norm, attn_wq, q_norm, sinks, attn_wo,
          ffn_norm, w_gate, w_up, w_down):
    B, T, _ = x.shape
    new_states = []
    k_all = None
    v_all = None
    for l in range(DEPTH):
        if l < N_A_LAYERS:
            h = rms_norm(x, hgrn_norm[l])
            o, s_fin = hgrn2_mixer(h, hgrn_wq[l], hgrn_wf[l], hgrn_wi[l], hgrn_wg[l],
                                   lower_bounds[l], hgrn_onorm[l], hgrn_wo[l], s0[l], chunk)
            new_states.append(s_fin)
        else:
            j = l - N_A_LAYERS
            if j == 0:
                hkv = rms_norm(x, kv_norm)
                k_new = rope(rms_norm((hkv @ w_k).reshape(B, T, ATTN_KV_HEADS, ATTN_HEAD_DIM), k_norm), pos)
                v_new = (hkv @ w_v).reshape(B, T, ATTN_KV_HEADS, ATTN_HEAD_DIM)
                if past_k is None:
                    k_all, v_all = k_new, v_new
                else:
                    k_all = jnp.concatenate([past_k.astype(k_new.dtype), k_new], axis=1)
                    v_all = jnp.concatenate([past_v.astype(v_new.dtype), v_new], axis=1)
            h = rms_norm(x, attn_norm[j])
            q = rope(rms_norm((h @ attn_wq[j]).reshape(B, T, ATTN_Q_HEADS, ATTN_HEAD_DIM), q_norm[j]), pos)
            if past_k is None:
                a = swa_prompt(q, k_all, v_all, sinks[j])
            else:
                a = swa_sample(q, k_all, v_all, sinks[j])
            o = a @ attn_wo[j]
        x = x + o
        x = x + swiglu(rms_norm(x, ffn_norm[l]), w_gate[l], w_up[l], w_down[l])
    return x, jnp.stack(new_states), k_all[:, -WINDOW:], v_all[:, -WINDOW:]


def setup_inputs(seed: int = 0) -> dict:
    key = jax.random.key(seed)
    ks = jax.random.split(key, 32)
    f32 = jnp.float32

    def nrm(k, shape, scale):
        return jax.random.normal(k, shape, f32) * scale

    def gain(k, shape):
        return 1.0 + 0.05 * jax.random.normal(k, shape, f32)

    D = D_MODEL
    KVW = ATTN_KV_HEADS * ATTN_HEAD_DIM
    QW = ATTN_Q_HEADS * ATTN_HEAD_DIM
    return {
        'x_prompt': nrm(ks[0], (BATCH, SEQ, D), 1.0),
        'x_sample': nrm(ks[1], (DEC_BATCH, DEC_SEQ, D), 1.0),
        'state_hgrn': nrm(ks[2], (N_A_LAYERS, DEC_BATCH, HGRN_HEADS, HGRN_DK, HGRN_DV), 0.5),
        'cache_k_win': nrm(ks[3], (DEC_BATCH, WINDOW, ATTN_KV_HEADS, ATTN_HEAD_DIM), 1.0),
        'cache_v_win': nrm(ks[4], (DEC_BATCH, WINDOW, ATTN_KV_HEADS, ATTN_HEAD_DIM), 1.0),
        'hgrn_norm': gain(ks[5], (N_A_LAYERS, D)),
        'hgrn_wq': nrm(ks[6], (N_A_LAYERS, D, HGRN_HEADS * HGRN_DK), D ** -0.5),
        'hgrn_wf': nrm(ks[7], (N_A_LAYERS, D, HGRN_HEADS * HGRN_DK), D ** -0.5),
        'hgrn_wi': nrm(ks[8], (N_A_LAYERS, D, HGRN_HEADS * HGRN_DV), D ** -0.5),
        'hgrn_wg': nrm(ks[9], (N_A_LAYERS, D, D), D ** -0.5),
        'hgrn_lb_logits': nrm(ks[10], (N_A_LAYERS, HGRN_HEADS * HGRN_DK), 0.5),
        'hgrn_onorm': gain(ks[11], (N_A_LAYERS, HGRN_DV)),
        'hgrn_wo': nrm(ks[12], (N_A_LAYERS, D, D), D ** -0.5),
        'kv_norm': gain(ks[13], (D,)),
        'w_k': nrm(ks[14], (D, KVW), D ** -0.5),
        'w_v': nrm(ks[15], (D, KVW), D ** -0.5),
        'k_norm': gain(ks[16], (ATTN_HEAD_DIM,)),
        'attn_norm': gain(ks[17], (N_B_LAYERS, D)),
        'attn_wq': nrm(ks[18], (N_B_LAYERS, D, QW), D ** -0.5),
        'q_norm': gain(ks[19], (N_B_LAYERS, ATTN_HEAD_DIM)),
        'sinks': nrm(ks[20], (N_B_LAYERS, ATTN_Q_HEADS), 0.5),
        'attn_wo': nrm(ks[21], (N_B_LAYERS, QW, D), QW ** -0.5),
        'ffn_norm': gain(ks[22], (DEPTH, D)),
        'w_gate': nrm(ks[23], (DEPTH, D, D_FF), D ** -0.5),
        'w_up': nrm(ks[24], (DEPTH, D, D_FF), D ** -0.5),
        'w_down': nrm(ks[25], (DEPTH, D_FF, D), D_FF ** -0.5),
    }


def reference(x_prompt, x_sample, state_hgrn, cache_k_win, cache_v_win,
              hgrn_norm, hgrn_wq, hgrn_wf, hgrn_wi, hgrn_wg, hgrn_lb_logits, hgrn_onorm, hgrn_wo,
              kv_norm, w_k, w_v, k_norm,
              attn_norm, attn_wq, q_norm, sinks, attn_wo,
              ffn_norm, w_gate, w_up, w_down):
    sm = jax.nn.softmax(hgrn_lb_logits.astype(jnp.float32), axis=0)
    lower_bounds = jnp.cumsum(sm, axis=0) - sm[0:1]
    weights = (hgrn_norm, hgrn_wq, hgrn_wf, hgrn_wi, hgrn_wg, lower_bounds, hgrn_onorm, hgrn_wo,
               kv_norm, w_k, w_v, k_norm,
               attn_norm, attn_wq, q_norm, sinks, attn_wo,
               ffn_norm, w_gate, w_up, w_down)
    s0_prompt = jnp.zeros((N_A_LAYERS, x_prompt.shape[0], HGRN_HEADS, HGRN_DK, HGRN_DV), jnp.float32)
    y_prompt, st_prompt, kw_prompt, vw_prompt = trunk(
        x_prompt, jnp.arange(x_prompt.shape[1]), s0_prompt, HGRN_CHUNK, None, None, *weights)
    n_new = x_sample.shape[1]
    y_sample, st_sample, kw_sample, vw_sample = trunk(
        x_sample, PAST_LEN + jnp.arange(n_new), state_hgrn, n_new, cache_k_win, cache_v_win, *weights)
    return (y_prompt, y_sample, st_prompt, st_sample, kw_prompt, vw_prompt, kw_sample, vw_sample)
```

```cpp
#include <hip/hip_runtime.h>
#include <cstdio>
#include <cstdint>
namespace pg8 {
#define PG8_LAS __attribute__((address_space(3)))
typedef unsigned short bf16_t;
typedef short bf16x8 __attribute__((ext_vector_type(8)));
typedef float f32x4 __attribute__((ext_vector_type(4)));
typedef unsigned u32x4 __attribute__((ext_vector_type(4)));
constexpr int BM = 256, BK = 64, HALF = 128, HTB = HALF * BK * 2  , STAGE_BYTES = 8 * HTB, NXCD = 8, WGM = 8;

__host__ __device__ __forceinline__ int lds_byte(int r, int c) { const int st = (r >> 4) * 2 + (c >> 5), rr = r & 15, cc = c & 31, ob = rr * 64 + cc * 2; return st * 1024 + (ob ^ (((ob >> 9) & 1) << 5)); }
__host__ __device__ __forceinline__ void stage_rc(int b, int& R, int& C) { const int st = b / 1024, sb = b % 1024, swz = sb ^ (((sb >> 9) & 1) << 5); R = (st >> 1) * 16 + swz / 64; C = (st & 1) * 32 + (swz % 64) / 2; }
__host__ __device__ __forceinline__ int perm32(int rho) { const int n = rho >> 4, i = rho & 15; return 8 * (i >> 2) + 4 * n + (i & 3); }

struct Unit { int pm, pn; };
struct Gemm { const bf16_t* A; const bf16_t* Bt; int M, N, K; };

struct StaticOrder {
    int nM, nN, nwg, G, c;
    __host__ __device__ void init(int M, int N, int G_, int c_) { nM = M / BM; nN = N / BM; nwg = nM * nN; G = G_; c = c_; }
    __host__ __device__ bool next(int i, Unit& u) const {
        const long L = (long)i * G + c; if (L >= nwg) return false;
        int wgid = (int)L; { const int q = nwg / NXCD, r = nwg % NXCD, xcd = wgid % NXCD, off = wgid / NXCD; wgid = (xcd < r ? xcd * (q + 1) : r * (q + 1) + (xcd - r) * q) + off; }
        const int nig = WGM * nN, gid = wgid / nig, fm = gid * WGM, gsz = (nM - fm) < WGM ? (nM - fm) : WGM;
        u.pm = fm + ((wgid % nig) % gsz); u.pn = (wgid % nig) / gsz; return true;
    }
    __device__ __forceinline__ void a_ready(const Unit&) const {}
    __device__ __forceinline__ void done(const Unit&) const {}
};


#define PG8_GAS __attribute__((address_space(1)))
__device__ __forceinline__ unsigned cvt_pk_bf16(float lo, float hi) { unsigned r; asm volatile("v_cvt_pk_bf16_f32 %0, %1, %2" : "=v"(r) : "v"(lo), "v"(hi)); return r; }
__device__ __forceinline__ float silu_f(float a) { return a / (1.0f + __expf(-a)); }
__device__ __forceinline__ u32x4 pack8(const f32x4 v0, const f32x4 v1) { u32x4 w; w.x = cvt_pk_bf16(v0[0], v0[1]); w.y = cvt_pk_bf16(v0[2], v0[3]); w.z = cvt_pk_bf16(v1[0], v1[1]); w.w = cvt_pk_bf16(v1[2], v1[3]); return w; }

struct EpiResid {
    static constexpr bool PERM = false, AFTER_DRAIN = false;
    float* X; int ldc;
    __device__ __forceinline__ void operator()(const f32x4 (&acc)[2][2][4][2], const Unit& u, int wr, int wc, int fr, int fq) const {
        const int row0 = u.pm * BM + wr * 64 + fr, col0 = u.pn * BM + wc * 32 + 4 * fq;
#pragma unroll
        for (int ai = 0; ai < 2; ++ai)
#pragma unroll
            for (int m = 0; m < 4; ++m) { PG8_GAS float* rowp = (PG8_GAS float*)X + (size_t)(row0 + ai * HALF + m * 16) * ldc + col0;
                f32x4 old[2][2];
#pragma unroll
                for (int bj = 0; bj < 2; ++bj)
#pragma unroll
                    for (int n = 0; n < 2; ++n) old[bj][n] = *(const PG8_GAS f32x4*)(rowp + bj * HALF + n * 16);
#pragma unroll
                for (int bj = 0; bj < 2; ++bj)
#pragma unroll
                    for (int n = 0; n < 2; ++n) *(PG8_GAS f32x4*)(rowp + bj * HALF + n * 16) = old[bj][n] + acc[ai][bj][m][n];
                asm volatile("" ::: "memory"); }
    }
};
struct EpiRaw {
    static constexpr bool PERM = false, AFTER_DRAIN = false;
    float* C; int ldc;
    __device__ __forceinline__ void operator()(const f32x4 (&acc)[2][2][4][2], const Unit& u, int wr, int wc, int fr, int fq) const {
        const int row0 = u.pm * BM + wr * 64 + fr, col0 = u.pn * BM + wc * 32 + 4 * fq;
#pragma unroll
        for (int ai = 0; ai < 2; ++ai)
#pragma unroll
            for (int m = 0; m < 4; ++m) { PG8_GAS float* rowp = (PG8_GAS float*)C + (size_t)(row0 + ai * HALF + m * 16) * ldc + col0;
#pragma unroll
                for (int bj = 0; bj < 2; ++bj)
#pragma unroll
                    for (int n = 0; n < 2; ++n) *(PG8_GAS f32x4*)(rowp + bj * HALF + n * 16) = acc[ai][bj][m][n]; }
    }
};
struct EpiFfn1 {
    static constexpr bool PERM = true, AFTER_DRAIN = false;
    bf16_t* O; int ldc;
    __device__ __forceinline__ void operator()(const f32x4 (&acc)[2][2][4][2], const Unit& u, int wr, int wc, int fr, int fq) const {
        const int row0 = u.pm * BM + wr * 64 + fr, col0 = u.pn * HALF + wc * 32 + 8 * fq;
#pragma unroll
        for (int ai = 0; ai < 2; ++ai)
#pragma unroll
            for (int m = 0; m < 4; ++m) { PG8_GAS bf16_t* rowp = (PG8_GAS bf16_t*)O + (size_t)(row0 + ai * HALF + m * 16) * ldc + col0;
                f32x4 v0, v1;
#pragma unroll
                for (int e = 0; e < 4; ++e) { v0[e] = silu_f(acc[ai][0][m][0][e]) * acc[ai][1][m][0][e]; v1[e] = silu_f(acc[ai][0][m][1][e]) * acc[ai][1][m][1][e]; }
                *(PG8_GAS u32x4*)rowp = pack8(v0, v1); }
    }
};
struct EpiHproj {
    static constexpr bool PERM = true, AFTER_DRAIN = false;
    bf16_t *Q, *KK; float* LF; const float* lb;
    __device__ __forceinline__ void operator()(const f32x4 (&acc)[2][2][4][2], const Unit& u, int wr, int wc, int fr, int fq) const {
        const int row0 = u.pm * BM + wr * 64 + fr; const int type = u.pn >> 3; const int col0 = (u.pn & 7) * BM + wc * 32 + 8 * fq;
        if (type == 1) {
            f32x4 lbv[2][2];
#pragma unroll
            for (int bj = 0; bj < 2; ++bj)
#pragma unroll
                for (int n = 0; n < 2; ++n) lbv[bj][n] = *(const PG8_GAS f32x4*)((const PG8_GAS float*)lb + col0 + bj * HALF + 4 * n);
#pragma unroll
            for (int ai = 0; ai < 2; ++ai)
#pragma unroll
                for (int m = 0; m < 4; ++m) { const size_t off = (size_t)(row0 + ai * HALF + m * 16) * 2048 + col0;
#pragma unroll
                    for (int bj = 0; bj < 2; ++bj) { f32x4 lf[2], kk[2];
#pragma unroll
                        for (int n = 0; n < 2; ++n)
#pragma unroll
                            for (int e = 0; e < 4; ++e) { float z = acc[ai][bj][m][n][e]; z = fminf(fmaxf(z, -80.f), 80.f); const float ex = expf(-z), s = 1.0f / (1.0f + ex), l = lbv[bj][n][e];
                                const float f = l + (1.0f - l) * s; lf[n][e] = logf(fmaxf(f, 1e-30f)); kk[n][e] = (1.0f - l) * (ex * s); }
                        *(PG8_GAS f32x4*)((PG8_GAS float*)LF + off + bj * HALF) = lf[0]; *(PG8_GAS f32x4*)((PG8_GAS float*)LF + off + bj * HALF + 4) = lf[1];
                        *(PG8_GAS u32x4*)((PG8_GAS bf16_t*)KK + off + bj * HALF) = pack8(kk[0], kk[1]); } }
        } else {
            PG8_GAS bf16_t* dst = (PG8_GAS bf16_t*)Q + (size_t)type * ((size_t)33 << 19);
#pragma unroll
            for (int ai = 0; ai < 2; ++ai)
#pragma unroll
                for (int m = 0; m < 4; ++m) { const size_t off = (size_t)(row0 + ai * HALF + m * 16) * 2048 + col0;
#pragma unroll
                    for (int bj = 0; bj < 2; ++bj) { f32x4 v0 = acc[ai][bj][m][0], v1 = acc[ai][bj][m][1];
                        if (type == 0) {
#pragma unroll
                            for (int e = 0; e < 4; ++e) { v0[e] = silu_f(v0[e]) * 0.08838834764831845f; v1[e] = silu_f(v1[e]) * 0.08838834764831845f; } }
                        else if (type == 3) {
#pragma unroll
                            for (int e = 0; e < 4; ++e) { v0[e] = silu_f(v0[e]); v1[e] = silu_f(v1[e]); } }
                        *(PG8_GAS u32x4*)(dst + off + bj * HALF) = pack8(v0, v1); } }
        }
    }
};
template <class Epi, class Sched, bool ALIGN_EPI = false, bool SP2 = false>
__device__ __forceinline__ void gemm_phase(PG8_LAS unsigned char* lds, const Gemm g, const Sched& S, const Epi& E, const int tid) {
    const int wid = __builtin_amdgcn_readfirstlane(tid >> 6), lane = tid & 63, wr = wid >> 2, wc = wid & 3, fr = lane & 15, fq = lane >> 4;
    const int K = g.K, nt = K / BK;
    unsigned voffA[2], voffB[2];
#pragma unroll
    for (int i = 0; i < 2; ++i) { int R, C; stage_rc(tid * 16 + i * 8192, R, C); const int Rb = Epi::PERM ? ((R & ~31) + perm32(R & 31)) : R;
        voffA[i] = (unsigned)(R * K + C) * 2u; voffB[i] = (unsigned)(Rb * K + C) * 2u; }
    const size_t kstep = (size_t)(BK * 2);
    const size_t hstep = (size_t)HALF * K * 2;
    const size_t tstep = 2 * hstep;
    const unsigned ldsw = (unsigned)wid * 1024u;
    const int aoff = lds_byte(wr * 64 + fr, fq * 8), boff = lds_byte(wc * 32 + fr, fq * 8);
#define PG8_SA(b, h) (((b) * 2 + (h)) * HTB)
#define PG8_SB(b, h) ((4 + (b) * 2 + (h)) * HTB)
#define PG8_STAGE(bufoff, gbase, voff) do { _Pragma("unroll") for (int _i = 0; _i < 2; ++_i) \
        __builtin_amdgcn_global_load_lds((const unsigned*)((const char*)(gbase) + (voff)[_i]), (PG8_LAS unsigned*)(lds + (bufoff) + ldsw + _i * 8192), 16, 0, 0); } while (0)
#define PG8_LDA(dst, b, h) do { _Pragma("unroll") for (int m = 0; m < 4; ++m) _Pragma("unroll") for (int k = 0; k < 2; ++k) dst[m][k] = *(const PG8_LAS bf16x8*)(lds + PG8_SA(b, h) + aoff + m * 2048 + k * 1024); } while (0)
#define PG8_LDB(dst, b, h) do { _Pragma("unroll") for (int n = 0; n < 2; ++n) _Pragma("unroll") for (int k = 0; k < 2; ++k) dst[n][k] = *(const PG8_LAS bf16x8*)(lds + PG8_SB(b, h) + boff + n * 2048 + k * 1024); } while (0)
#define PG8_MMA(ai, bj, At, Bt) do { __builtin_amdgcn_s_setprio(1); _Pragma("unroll") for (int m = 0; m < 4; ++m) _Pragma("unroll") for (int n = 0; n < 2; ++n) _Pragma("unroll") for (int k = 0; k < 2; ++k) \
        acc[ai][bj][m][n] = __builtin_amdgcn_mfma_f32_16x16x32_bf16(Bt[n][k], At[m][k], acc[ai][bj][m][n], 0, 0, 0); __builtin_amdgcn_s_setprio(0); } while (0)
#define PG8_WAIT_V(n) asm volatile("s_waitcnt vmcnt(" #n ")" ::: "memory")
#define PG8_WAIT_L(n) asm volatile("s_waitcnt lgkmcnt(" #n ")" ::: "memory")
#define PG8_BAR __builtin_amdgcn_s_barrier()
#define PG8_SCHED __builtin_amdgcn_sched_barrier(0)
    Unit cur, nxt; int ui = 0;
    if (!S.next(0, cur)) return;
    f32x4 acc[2][2][4][2];
#pragma unroll
    for (int a = 0; a < 2; ++a)
#pragma unroll
        for (int b = 0; b < 2; ++b)
#pragma unroll
            for (int m = 0; m < 4; ++m)
#pragma unroll
                for (int n = 0; n < 2; ++n) acc[a][b][m][n] = (f32x4){0.f, 0.f, 0.f, 0.f};
    bf16x8 At[4][2], B0[2][2], B1[2][2];
    const char* cA = (const char*)g.A + (size_t)cur.pm * tstep; const char* cB = (const char*)g.Bt + (size_t)cur.pn * tstep;
    S.a_ready(cur);
    if constexpr (SP2) {
        PG8_STAGE(PG8_SB(0, 0), cB, voffB); PG8_STAGE(PG8_SB(0, 1), cB + hstep, voffB); PG8_STAGE(PG8_SA(0, 0), cA, voffA); PG8_STAGE(PG8_SA(0, 1), cA + hstep, voffA);
        if (wr == 1) PG8_BAR;
        PG8_WAIT_V(2); PG8_BAR;
        PG8_STAGE(PG8_SB(1, 0), cB + kstep, voffB); PG8_STAGE(PG8_SA(1, 0), cA + kstep, voffA); PG8_STAGE(PG8_SB(1, 1), cB + hstep + kstep, voffB);
        PG8_WAIT_V(6); PG8_BAR;
    } else {
        PG8_STAGE(PG8_SB(0, 0), cB, voffB); PG8_STAGE(PG8_SA(0, 0), cA, voffA); PG8_STAGE(PG8_SB(0, 1), cB + hstep, voffB); PG8_STAGE(PG8_SA(0, 1), cA + hstep, voffA);
        if (wr == 1) PG8_BAR;
        PG8_WAIT_V(4); PG8_BAR;
        PG8_STAGE(PG8_SB(1, 0), cB + kstep, voffB); PG8_STAGE(PG8_SA(1, 0), cA + kstep, voffA); PG8_STAGE(PG8_SB(1, 1), cB + hstep + kstep, voffB);
        PG8_WAIT_V(6); PG8_BAR;
    }
    for (;;) {
        const bool has_next = S.next(ui + 1, nxt);
        const char* nA = has_next ? (const char*)g.A + (size_t)nxt.pm * tstep : cA; const char* nB = has_next ? (const char*)g.Bt + (size_t)nxt.pn * tstep : cB;
        for (int t = 0; t < nt; t += 2) {
            const bool last = (t == nt - 2);
            const char* a1 = cA + (size_t)(t + 1) * kstep;
            const char* a2 = last ? nA : cA + (size_t)(t + 2) * kstep; const char* b2 = last ? nB : cB + (size_t)(t + 2) * kstep;
            const char* a3 = a2 + kstep; const char* b3 = b2 + kstep;
            if (last && has_next) S.a_ready(nxt);
            if constexpr (SP2) {
            PG8_LDB(B0, 0, 0); PG8_LDB(B1, 0, 1); PG8_SCHED; PG8_LDA(At, 0, 0); PG8_STAGE(PG8_SA(1, 1), a1 + hstep, voffA);
            PG8_WAIT_V(8); PG8_WAIT_L(0); PG8_BAR; PG8_MMA(0, 0, At, B0); PG8_MMA(0, 1, At, B1); PG8_BAR; PG8_SCHED;
            PG8_LDA(At, 0, 1); PG8_STAGE(PG8_SB(0, 0), b2, voffB); PG8_STAGE(PG8_SB(0, 1), b2 + hstep, voffB); PG8_STAGE(PG8_SA(0, 0), a2, voffA);
            PG8_WAIT_V(8); PG8_WAIT_L(0); PG8_BAR; PG8_MMA(1, 0, At, B0); PG8_MMA(1, 1, At, B1); PG8_BAR; PG8_SCHED;
            PG8_LDB(B0, 1, 0); PG8_LDB(B1, 1, 1); PG8_SCHED; PG8_LDA(At, 1, 0); PG8_STAGE(PG8_SA(0, 1), a2 + hstep, voffA);
            PG8_WAIT_V(8); PG8_WAIT_L(0); PG8_BAR; PG8_MMA(0, 0, At, B0); PG8_MMA(0, 1, At, B1); PG8_BAR; PG8_SCHED;
            PG8_LDA(At, 1, 1); PG8_STAGE(PG8_SB(1, 0), b3, voffB); PG8_STAGE(PG8_SB(1, 1), b3 + hstep, voffB); PG8_STAGE(PG8_SA(1, 0), a3, voffA);
            PG8_WAIT_V(8); PG8_WAIT_L(0); PG8_BAR; PG8_MMA(1, 0, At, B0); PG8_MMA(1, 1, At, B1); PG8_BAR; PG8_SCHED;
            } else {
            PG8_LDB(B0, 0, 0); PG8_SCHED; PG8_LDA(At, 0, 0); PG8_STAGE(PG8_SA(1, 1), a1 + hstep, voffA);
            PG8_WAIT_L(8); PG8_BAR; PG8_WAIT_L(0); PG8_MMA(0, 0, At, B0); PG8_BAR; PG8_SCHED;
            PG8_LDB(B1, 0, 1); PG8_STAGE(PG8_SB(0, 0), b2, voffB);
            PG8_BAR; PG8_WAIT_L(0); PG8_MMA(0, 1, At, B1); PG8_BAR;
            PG8_LDA(At, 0, 1); PG8_STAGE(PG8_SA(0, 0), a2, voffA);
            PG8_BAR; PG8_WAIT_L(0); PG8_MMA(1, 0, At, B0); PG8_BAR; PG8_SCHED;
            PG8_STAGE(PG8_SB(0, 1), b2 + hstep, voffB);
            PG8_WAIT_V(6); PG8_BAR; PG8_MMA(1, 1, At, B1); PG8_BAR;
            PG8_LDB(B0, 1, 0); PG8_SCHED; PG8_LDA(At, 1, 0); PG8_STAGE(PG8_SA(0, 1), a2 + hstep, voffA);
            PG8_WAIT_L(8); PG8_BAR; PG8_WAIT_L(0); PG8_MMA(0, 0, At, B0); PG8_BAR; PG8_SCHED;
            PG8_LDB(B1, 1, 1); PG8_STAGE(PG8_SB(1, 0), b3, voffB);
            PG8_BAR; PG8_WAIT_L(0); PG8_MMA(0, 1, At, B1); PG8_BAR;
            PG8_LDA(At, 1, 1); PG8_STAGE(PG8_SA(1, 0), a3, voffA);
            PG8_BAR; PG8_WAIT_L(0); PG8_MMA(1, 0, At, B0); PG8_BAR; PG8_SCHED;
            PG8_STAGE(PG8_SB(1, 1), b3 + hstep, voffB);
            PG8_WAIT_V(6); PG8_BAR; PG8_MMA(1, 1, At, B1); PG8_BAR;
            }
        }
        if constexpr (ALIGN_EPI) { if (wr == 0) PG8_BAR; }
        if constexpr (!Epi::AFTER_DRAIN) { E(acc, cur, wr, wc, fr, fq); S.done(cur); }
        if (!has_next) break;
#pragma unroll
        for (int a = 0; a < 2; ++a)
#pragma unroll
            for (int b = 0; b < 2; ++b)
#pragma unroll
                for (int m = 0; m < 4; ++m)
#pragma unroll
                    for (int n = 0; n < 2; ++n) acc[a][b][m][n] = (f32x4){0.f, 0.f, 0.f, 0.f};
        cur = nxt; cA = nA; cB = nB; ++ui;
        if constexpr (ALIGN_EPI) { if (wr == 1) PG8_BAR; }
    }
    PG8_WAIT_V(0);
    if constexpr (!ALIGN_EPI) { if (wr == 0) PG8_BAR; }
    PG8_BAR;
    if constexpr (Epi::AFTER_DRAIN) { E.fused(acc, cur, wr, wc, fr, fq, lds, wid, lane); S.done(cur); }
#undef PG8_SA
#undef PG8_SB
#undef PG8_STAGE
#undef PG8_LDA
#undef PG8_LDB
#undef PG8_MMA
#undef PG8_WAIT_V
#undef PG8_WAIT_L
#undef PG8_BAR
#undef PG8_SCHED
}
}

constexpr int NWAVES = 8, NTHREADS = 512;
constexpr int DM = 2048, DFF = 5632, TP = 4096, NBP = 2, NBS = 32, TS = 8;
constexpr int MP = NBP * TP  , MS = NBS * TS  , MROWS = MP + MS  ;
constexpr int NH = 16, DK = 128;
constexpr int NQH = 32, NKV = 8, HD = 64, KVW = NKV * HD  , WIN = 128;
constexpr int NPOS = TP + TS;
constexpr float RMS_EPS = 1e-6f;
constexpr size_t O_Y = 0, O_STP = (size_t)MROWS * DM, O_STS = O_STP + (size_t)2 * NBP * NH * DK * DK, O_KWP = O_STS + (size_t)2 * NBS * NH * DK * DK,
                 O_VWP = O_KWP + (size_t)NBP * WIN * KVW, O_KWS = O_VWP + (size_t)NBP * WIN * KVW, O_VWS = O_KWS + (size_t)NBS * WIN * KVW, O_END = O_VWS + (size_t)NBS * WIN * KVW;
static_assert(O_END == 39583744, "output size");
constexpr size_t MiB = 1u << 20;
constexpr size_t WS_CTL = 0, CTL_ZERO_BYTES = 1 * MiB;
constexpr size_t WS_LB = 1 * MiB, WS_ROPE = 1 * MiB + 65536;
constexpr size_t WS_WH = 4 * MiB, WS_WOH = WS_WH + 64 * MiB, WS_WQKV0 = WS_WOH + 16 * MiB, WS_WQ1 = WS_WQKV0 + 12 * MiB, WS_WOA = WS_WQ1 + 8 * MiB, WS_WGU = WS_WOA + 16 * MiB, WS_WD = WS_WGU + 176 * MiB;
constexpr size_t WS_H = WS_WD + 88 * MiB;
constexpr size_t WS_P = WS_H + 33 * MiB;
constexpr size_t WS_Q = WS_P, WS_KK = WS_P + 33 * MiB, WS_V = WS_P + 66 * MiB, WS_GT = WS_P + 99 * MiB, WS_LF = WS_P + 132 * MiB;
constexpr size_t WS_ACT = WS_P;
constexpr size_t WS_RAW = WS_P, WS_QF = WS_P + 99 * MiB, WS_KF = WS_P + 165 * MiB, WS_VF = WS_KF + (size_t)MROWS * KVW * 4;
constexpr size_t WS_END = WS_P + 198 * MiB;
static_assert(WS_KK - WS_Q == 33 * MiB && WS_V - WS_Q == 66 * MiB && WS_GT - WS_Q == 99 * MiB, "EpiHproj addresses Q|KK|V|GT by type * 33 MiB");
static_assert(WS_ROPE + (size_t)NPOS * 32 * 8 <= WS_WH && WS_VF + (size_t)MROWS * KVW * 4 <= WS_END && WS_ACT + (size_t)MROWS * DFF * 2 <= WS_KF, "ws map");
constexpr int CW_BAR = 4096;
constexpr int RING_BYTES = 131072, LDSCTL_OFF = RING_BYTES, MISC_OFF = LDSCTL_OFF + 320, LDS_BYTES = 147456;

#define LAS __attribute__((address_space(3)))
typedef unsigned short bf16;
typedef float f32x4 __attribute__((ext_vector_type(4)));
typedef float f32x2 __attribute__((ext_vector_type(2)));
typedef unsigned u32x4 __attribute__((ext_vector_type(4)));
typedef unsigned u32x2 __attribute__((ext_vector_type(2)));
__device__ __forceinline__ float bf2f(unsigned short b) { return __uint_as_float(((unsigned)b) << 16); }
__device__ __forceinline__ float wave_sum(float v) {
#pragma unroll
    for (int o = 1; o < 64; o <<= 1) v += __shfl_xor(v, o);
    return v;
}
__device__ __forceinline__ float wave_max(float v) {
#pragma unroll
    for (int o = 1; o < 64; o <<= 1) v = fmaxf(v, __shfl_xor(v, o));
    return v;
}
#define XB_TMO      128
#define XB_XCNT(j)  (256  + 64 * (j))
#define XB_XSUB(j)  (1280 + 64 * (j))
#define XB_XGEN(j)  (2304 + 64 * (j))
#define XB_TOP      3328
#define XB_TOPGEN   3392
#define XCD_BAR_WORDS 3456
#define XB_SPIN_CAP (1u << 18)

__device__ __forceinline__ unsigned xb_ld(unsigned* p)              { return __hip_atomic_load(p, __ATOMIC_RELAXED, __HIP_MEMORY_SCOPE_AGENT); }
__device__ __forceinline__ unsigned xb_add(unsigned* p, unsigned v) { return __hip_atomic_fetch_add(p, v, __ATOMIC_RELAXED, __HIP_MEMORY_SCOPE_AGENT); }
__device__ __forceinline__ unsigned xb_xcc_id() { return (unsigned)__builtin_amdgcn_s_getreg((3 << 11) | 20) & 0xFu; }
#define XB_SPIN(cond, bar) do { unsigned _sp = 0; while (cond) { __builtin_amdgcn_s_sleep(1); \
    if ((++_sp & 255u) == 0u) { if (xb_ld(&(bar)[XB_TMO])) break; if (_sp > XB_SPIN_CAP) { atomicAdd(&(bar)[XB_TMO], 1u); break; } } } } while (0)

struct XcdBarrier {
    unsigned* bar; unsigned x;
    volatile LAS unsigned* st;
};

__device__ __forceinline__ XcdBarrier xcd_barrier_post(unsigned* bar, volatile LAS unsigned* st) {
    XcdBarrier b; b.bar = bar; b.x = xb_xcc_id(); b.st = st;
    if (threadIdx.x == 0) (void)xb_add(&bar[XB_XCNT(b.x)], 1u);
    return b;
}
__device__ __forceinline__ void xcd_barrier_complete(unsigned* bar, unsigned x, unsigned& nloc, unsigned& nx) {
    const unsigned G = gridDim.x * gridDim.y * gridDim.z;
    unsigned sum, cnt, mine, sp = 0u;
    for (;;) {
        sum = 0u; cnt = 0u; mine = 0u;
#pragma unroll
        for (unsigned j = 0; j < 16; ++j) { const unsigned c = xb_ld(&bar[XB_XCNT(j)]); sum += c; cnt += (c > 0u) ? 1u : 0u; mine = (j == x) ? c : mine; }
        if (sum == G) break;
        __builtin_amdgcn_s_sleep(1);
        if ((++sp & 255u) == 0u) { if (xb_ld(&bar[XB_TMO])) break; if (sp > XB_SPIN_CAP) { atomicAdd(&bar[XB_TMO], 1u); break; } }
    }
    nloc = mine > 0u ? mine : 1u; nx = cnt > 0u ? cnt : 1u;
}

__device__ __forceinline__ void xcd_barrier(const XcdBarrier& b) {
    asm volatile("s_waitcnt vmcnt(0)" ::: "memory");
    __syncthreads();
    if (threadIdx.x == 0) {
        unsigned* bar = b.bar;
        __builtin_amdgcn_s_waitcnt(0);
        unsigned nloc = b.st[0], nx = b.st[1];
        if (nloc == 0u) { xcd_barrier_complete(bar, b.x, nloc, nx); b.st[0] = nloc; b.st[1] = nx; }
        const unsigned old = xb_add(&bar[XB_XSUB(b.x)], 1u);
        const unsigned gen = old / nloc;
        if (old + 1u == (gen + 1u) * nloc) {
            __builtin_amdgcn_fence(__ATOMIC_RELEASE, "agent");
            asm volatile("s_waitcnt vmcnt(0)" ::: "memory");
            const unsigned og = xb_add(&bar[XB_TOP], 1u);
            const unsigned tg = og / nx;
            if (og + 1u == (tg + 1u) * nx) xb_add(&bar[XB_TOPGEN], 1u);
            else XB_SPIN(xb_ld(&bar[XB_TOPGEN]) == tg, bar);
            __builtin_amdgcn_fence(__ATOMIC_ACQUIRE, "agent");
            xb_add(&bar[XB_XGEN(b.x)], 1u);
            asm volatile("s_waitcnt vmcnt(0)" ::: "memory");
        } else {
            XB_SPIN(xb_ld(&bar[XB_XGEN(b.x)]) == gen, bar);
            __builtin_amdgcn_fence(__ATOMIC_ACQUIRE, "agent");
            asm volatile("s_waitcnt vmcnt(0)" ::: "memory");
        }
    }
    __syncthreads();
}

struct Params { const float* in[26]; float* out; unsigned char* ws; int lo, hi; };
struct Frame { LAS unsigned char* lds; int tid, lane, wave, G, gw, NGW; };
#define CAS __attribute__((address_space(4)))
struct Args { const unsigned char CAS* k;
    __device__ __forceinline__ const float* in(int i) const { return *(const float* const CAS*)(k + 8 * i); }
    __device__ __forceinline__ float* out() const { return *(float* const CAS*)(k + 8 * 26); }
    __device__ __forceinline__ unsigned char* ws() const { return *(unsigned char* const CAS*)(k + 8 * 27); } };
__device__ __forceinline__ Args get_args() { Args a; a.k = (const unsigned char CAS*)__builtin_amdgcn_kernarg_segment_ptr(); asm volatile("" : "+s"(a.k)); return a; }
__device__ __forceinline__ Frame make_frame(LAS unsigned char* lds) { Frame F; int tid = threadIdx.x; asm volatile("" : "+v"(tid)); F.lds = lds; F.tid = tid; F.lane = tid & 63; F.wave = __builtin_amdgcn_readfirstlane(tid >> 6); F.G = gridDim.x;
    F.gw = blockIdx.x * NWAVES + F.wave; F.NGW = F.G * NWAVES; return F; }
#define LDS_WAIT() asm volatile("s_waitcnt lgkmcnt(0)" ::: "memory")
enum { I_XP = 0, I_XS, I_ST, I_CK, I_CV, I_HNORM, I_HWQ, I_HWF, I_HWI, I_HWG, I_LBL, I_ONORM, I_HWO, I_KVNORM, I_WK, I_WV, I_KNORM, I_ANORM, I_AWQ, I_QNORM, I_SINKS, I_AWO, I_FNORM, I_WG, I_WU, I_WDN };

__device__ __forceinline__ void conv_item(const float* W, int K, int N, const float* g, bf16* WT, int mode, int row_off, LAS float* scr, int item, int lane) {
    const int nblk = N / 32, kb = item / nblk, nb = item % nblk, k0 = 64 * kb, n0 = 32 * nb;
#pragma unroll 8
    for (int i = 0; i < 32; ++i) { const int kk = 2 * i + (lane >> 5); float w = W[(size_t)(k0 + kk) * N + n0 + (lane & 31)]; if (g) w *= g[k0 + kk]; scr[kk * 33 + (lane & 31)] = w; }
    LDS_WAIT();
    const int c = lane & 7;
    const int drow0 = (mode == 0) ? (row_off + n0) : ((n0 >> 7) * 256 + (n0 & 127) + (mode == 2 ? 128 : 0));
#pragma unroll
    for (int j = 0; j < 4; ++j) { const int n = (lane >> 3) + 8 * j; const LAS float* s = scr + (8 * c) * 33 + n;
        u32x4 o; o.x = pg8::cvt_pk_bf16(s[0 * 33], s[1 * 33]); o.y = pg8::cvt_pk_bf16(s[2 * 33], s[3 * 33]); o.z = pg8::cvt_pk_bf16(s[4 * 33], s[5 * 33]); o.w = pg8::cvt_pk_bf16(s[6 * 33], s[7 * 33]);
        *(u32x4*)(WT + (size_t)(drow0 + n) * K + k0 + 8 * c) = o; }
    LDS_WAIT();
}
__device__ __forceinline__ void phase_prologue(LAS unsigned char* lds) {
    const Args p = get_args(); Frame F = make_frame(lds); unsigned char* ws = p.ws(); float* const pout = p.out();
    LAS float* scr = (LAS float*)(F.lds + F.wave * 16384);
    constexpr int SQ = 2048 * 2048;
    constexpr int NIT_A = 10 * 2048, NIT_B = 2 * 512, NIT_C = 4 * 2048, NIT_D = 12 * 5632;
    for (int it = F.gw; it < NIT_A + NIT_B + NIT_C + NIT_D; it += F.NGW) {
        const float* W; const float* g = nullptr; bf16* dst; int K = 2048, N = 2048, mode = 0, row_off = 0, loc;
        if (it < NIT_A) { const int jid = it >> 11; loc = it & 2047;
            if (jid < 8) { const int l = jid >> 2, w = jid & 3; W = p.in(I_HWQ + w) + (size_t)l * SQ; g = p.in(I_HNORM) + l * DM; dst = (bf16*)(ws + WS_WH) + (size_t)l * 8192 * 2048; row_off = w * 2048; }
            else { const int l = jid - 8; W = p.in(I_HWO) + (size_t)l * SQ; dst = (bf16*)(ws + WS_WOH) + (size_t)l * SQ; } }
        else if (it < NIT_A + NIT_B) { const int r = it - NIT_A; const int w = r >> 9; loc = r & 511; N = 512; W = p.in(w ? I_WV : I_WK); g = p.in(I_KVNORM); dst = (bf16*)(ws + WS_WQKV0); row_off = w * 512; }
        else if (it < NIT_A + NIT_B + NIT_C) { const int r = it - NIT_A - NIT_B; const int jid = r >> 11; loc = r & 2047;
            if (jid == 0) { W = p.in(I_AWQ); g = p.in(I_ANORM); dst = (bf16*)(ws + WS_WQKV0); row_off = 1024; }
            else if (jid == 1) { W = p.in(I_AWQ) + SQ; g = p.in(I_ANORM) + DM; dst = (bf16*)(ws + WS_WQ1); }
            else { const int j = jid - 2; W = p.in(I_AWO) + (size_t)j * SQ; dst = (bf16*)(ws + WS_WOA) + (size_t)j * SQ; } }
        else { const int r = it - NIT_A - NIT_B - NIT_C; const int jid = r / 5632; loc = r % 5632; const int l = jid & 3, kind = jid >> 2;
            if (kind == 0) { W = p.in(I_WG) + (size_t)l * DM * DFF; g = p.in(I_FNORM) + l * DM; dst = (bf16*)(ws + WS_WGU) + (size_t)l * 2 * DFF * DM; N = DFF; mode = 1; }
            else if (kind == 1) { W = p.in(I_WU) + (size_t)l * DM * DFF; g = p.in(I_FNORM) + l * DM; dst = (bf16*)(ws + WS_WGU) + (size_t)l * 2 * DFF * DM; N = DFF; mode = 2; }
            else { W = p.in(I_WDN) + (size_t)l * DM * DFF; dst = (bf16*)(ws + WS_WD) + (size_t)l * DM * DFF; K = DFF; N = DM; } }
        conv_item(W, K, N, g, dst, mode, row_off, scr, loc, F.lane);
    }
    const int gt = F.gw * 64 + F.lane, NGT = F.NGW * 64;
    { const f32x4* s0 = (const f32x4*)p.in(I_XP); const f32x4* s1 = (const f32x4*)p.in(I_XS); f32x4* d = (f32x4*)(pout + O_Y);
      for (int i = gt; i < MP * DM / 4; i += NGT) d[i] = s0[i];
      for (int i = gt; i < MS * DM / 4; i += NGT) d[MP * DM / 4 + i] = s1[i]; }
    { float* LB = (float*)(ws + WS_LB); const float* lg = p.in(I_LBL);
      for (int c = gt; c < DM; c += NGT) { const float l0 = lg[c], l1 = lg[DM + c], m = fmaxf(l0, l1), e0 = expf(l0 - m), e1 = expf(l1 - m); LB[c] = 0.f; LB[DM + c] = e1 / (e0 + e1); } }
    { f32x2* TAB = (f32x2*)(ws + WS_ROPE);
      for (int idx = gt; idx < NPOS * 32; idx += NGT) { const int pi = idx >> 5, i = idx & 31; const double pos = (double)(pi < TP ? pi : 16384 + (pi - TP));
          double inv = 1.0; for (int k = 0; k < i; ++k) inv *= 0.7498942093324559;
          const double x = pos * inv, n = rint(x * 0.15915494309189535); double r = fma(-n, 6.283185307179586, x); r = fma(-n, 2.4492935982947064e-16, r);
          const double r2 = r * r; double s = 1.0, c = 1.0;
#pragma unroll
          for (int k = 14; k >= 1; --k) { s = 1.0 - r2 * (1.0 / (double)((2 * k) * (2 * k + 1))) * s; c = 1.0 - r2 * (1.0 / (double)((2 * k - 1) * (2 * k))) * c; }
          TAB[idx] = (f32x2){(float)c, (float)(r * s)}; } }
}

__device__ __forceinline__ void phase_norm(LAS unsigned char* lds) {
    const Args p = get_args(); Frame F = make_frame(lds); const float* X = p.out() + O_Y; bf16* H = (bf16*)(p.ws() + WS_H);
    for (int r = F.gw; r < MROWS; r += F.NGW) {
        const f32x4* xr = (const f32x4*)(X + (size_t)r * DM) + F.lane; f32x4 v[8]; float s = 0.f;
#pragma unroll
        for (int j = 0; j < 8; ++j) { v[j] = xr[64 * j]; s += (v[j].x * v[j].x + v[j].y * v[j].y) + (v[j].z * v[j].z + v[j].w * v[j].w); }
        const float rstd = 1.0f / sqrtf(wave_sum(s) * (1.0f / DM) + RMS_EPS);
        u32x2* o8 = (u32x2*)(H + (size_t)r * DM) + F.lane;
#pragma unroll
        for (int j = 0; j < 8; ++j) o8[64 * j] = (u32x2){pg8::cvt_pk_bf16(v[j].x * rstd, v[j].y * rstd), pg8::cvt_pk_bf16(v[j].z * rstd, v[j].w * rstd)};
    }
}

__device__ __forceinline__ void phase_gla_simple(LAS unsigned char* lds, int l) {
    const Args p = get_args(); Frame F = make_frame(lds); unsigned char* ws = p.ws(); float* const pout = p.out();
    LAS float* sf = (LAS float*)F.lds; LAS float* sk = sf + 2048; LAS float* sq = sf + 4096; LAS float* sv = sf + 6144; LAS float* sg = sf + 8192; LAS float* red = sf + 10240;
    const bf16* Q = (const bf16*)(ws + WS_Q); const bf16* KK = (const bf16*)(ws + WS_KK); const bf16* V = (const bf16*)(ws + WS_V); const bf16* GT = (const bf16*)(ws + WS_GT); const float* LF = (const float*)(ws + WS_LF);
    bf16* H = (bf16*)(ws + WS_H); const float* gon = p.in(I_ONORM) + l * DK;
    const int tid = F.tid, v = tid & 127, dg = tid >> 7;
    for (int it = blockIdx.x; it < NBP * NH + NBS * NH; it += F.G) {
        int b, h, row0, T; const float* sin_; float* sout;
        if (it < NBP * NH) { b = it >> 4; h = it & 15; row0 = b * TP; T = TP; sin_ = nullptr; sout = pout + O_STP + ((size_t)(l * NBP + b) * NH + h) * DK * DK; }
        else { const int s = it - NBP * NH; b = s >> 4; h = s & 15; row0 = MP + b * TS; T = TS; sin_ = p.in(I_ST) + ((size_t)(l * NBS + b) * NH + h) * DK * DK; sout = pout + O_STS + ((size_t)(l * NBS + b) * NH + h) * DK * DK; }
        float S[32];
#pragma unroll
        for (int i = 0; i < 32; ++i) S[i] = sin_ ? sin_[(size_t)(dg * 32 + i) * DK + v] : 0.f;
        for (int t0 = 0; t0 < T; t0 += 16) {
            const int nt = (T - t0) < 16 ? (T - t0) : 16;
            __syncthreads();
            for (int e = tid; e < nt * 128; e += NTHREADS) { const int t = e >> 7, c = e & 127; const size_t gi = (size_t)(row0 + t0 + t) * DM + h * DK + c;
                sf[e] = expf(LF[gi]); sk[e] = bf2f(KK[gi]); sq[e] = bf2f(Q[gi]); sv[e] = bf2f(V[gi]); sg[e] = bf2f(GT[gi]); }
            __syncthreads();
            for (int t = 0; t < nt; ++t) { float op = 0.f; const float vt = sv[t * 128 + v];
#pragma unroll
                for (int i4 = 0; i4 < 8; ++i4) { const f32x4 f4 = *(const LAS f32x4*)(sf + t * 128 + dg * 32 + i4 * 4), k4 = *(const LAS f32x4*)(sk + t * 128 + dg * 32 + i4 * 4), q4 = *(const LAS f32x4*)(sq + t * 128 + dg * 32 + i4 * 4);
#pragma unroll
                    for (int e = 0; e < 4; ++e) { S[i4 * 4 + e] = f4[e] * S[i4 * 4 + e] + k4[e] * vt; op += S[i4 * 4 + e] * q4[e]; } }
                red[(t * 4 + dg) * 128 + v] = op; }
            __syncthreads();
#pragma unroll
            for (int tt = 0; tt < 2; ++tt) { const int t = F.wave * 2 + tt;
                if (t < nt) { const int c0 = F.lane, c1 = F.lane + 64; float o0 = 0.f, o1 = 0.f;
#pragma unroll
                    for (int d4 = 0; d4 < 4; ++d4) { o0 += red[(t * 4 + d4) * 128 + c0]; o1 += red[(t * 4 + d4) * 128 + c1]; }
                    const float rstd = 1.0f / sqrtf(wave_sum(o0 * o0 + o1 * o1) * (1.0f / DK) + RMS_EPS);
                    const float y0 = o0 * rstd * gon[c0] * sg[t * 128 + c0], y1 = o1 * rstd * gon[c1] * sg[t * 128 + c1];
                    bf16* hp = H + (size_t)(row0 + t0 + t) * DM + h * DK;
                    hp[c0] = (bf16)(pg8::cvt_pk_bf16(y0, 0.f) & 0xffffu); hp[c1] = (bf16)(pg8::cvt_pk_bf16(y1, 0.f) & 0xffffu); } }
        }
#pragma unroll
        for (int i = 0; i < 32; ++i) sout[(size_t)(dg * 32 + i) * DK + v] = S[i];
    }
}

__device__ __forceinline__ void phase_post(LAS unsigned char* lds, int j) {
    const Args p = get_args(); Frame F = make_frame(lds); unsigned char* ws = p.ws(); float* const pout = p.out(); const float* RAW = (const float*)(ws + WS_RAW); float* QF = (float*)(ws + WS_QF); float* KF = (float*)(ws + WS_KF); float* VF = (float*)(ws + WS_VF);
    const int ld = (j == 0) ? 3072 : 2048, qoff = (j == 0) ? 1024 : 0; const float qn = p.in(I_QNORM)[j * HD + F.lane], kn = p.in(I_KNORM)[F.lane];
    const f32x2* TAB = (const f32x2*)(ws + WS_ROPE); const int lane = F.lane;
    for (int r = F.gw; r < MROWS; r += F.NGW) {
        const int pi = r < MP ? (r & (TP - 1)) : TP + ((r - MP) & (TS - 1)); const f32x2 cs = TAB[pi * 32 + (lane & 31)]; const float* raw = RAW + (size_t)r * ld;
        for (int hh = 0; hh < NQH; ++hh) { const float x = raw[qoff + hh * HD + lane]; const float y = x * (1.0f / sqrtf(wave_sum(x * x) * (1.0f / HD) + RMS_EPS)) * qn; const float pr = __shfl_xor(y, 32);
            QF[(size_t)r * DM + hh * HD + lane] = (lane < 32) ? (y * cs.x - pr * cs.y) : (y * cs.x + pr * cs.y); }
        if (j == 0) {
            float* kwo; float* vwo; bool wr_;
            if (r < MP) { const int t = r & (TP - 1), b = r >> 12; wr_ = t >= TP - WIN; kwo = pout + O_KWP + ((size_t)b * WIN + (t - (TP - WIN))) * KVW; vwo = pout + O_VWP + ((size_t)b * WIN + (t - (TP - WIN))) * KVW; }
            else { const int s = (r - MP) & (TS - 1), b = (r - MP) >> 3; wr_ = true; kwo = pout + O_KWS + ((size_t)b * WIN + (WIN - TS + s)) * KVW; vwo = pout + O_VWS + ((size_t)b * WIN + (WIN - TS + s)) * KVW; }
            for (int hh = 0; hh < NKV; ++hh) { const float x = raw[hh * HD + lane]; const float y = x * (1.0f / sqrtf(wave_sum(x * x) * (1.0f / HD) + RMS_EPS)) * kn; const float pr = __shfl_xor(y, 32);
                const float o = (lane < 32) ? (y * cs.x - pr * cs.y) : (y * cs.x + pr * cs.y); const float vv = raw[KVW + hh * HD + lane];
                KF[(size_t)r * KVW + hh * HD + lane] = o; VF[(size_t)r * KVW + hh * HD + lane] = vv;
                if (wr_) { kwo[hh * HD + lane] = o; vwo[hh * HD + lane] = vv; } }
        }
    }
    if (j == 0) {
        const int gt = F.gw * 64 + lane, NGT = F.NGW * 64; const float* ck = p.in(I_CK); const float* cv = p.in(I_CV); constexpr int PER = (WIN - TS) * KVW;
        for (int i = gt; i < NBS * PER; i += NGT) { const int b = i / PER, rem = i - b * PER; const size_t d = (size_t)b * WIN * KVW + rem, s = d + (size_t)TS * KVW; pout[O_KWS + d] = ck[s]; pout[O_VWS + d] = cv[s]; }
    }
}

__device__ __forceinline__ void phase_attn_simple(LAS unsigned char* lds, int j) {
    const Args p = get_args(); Frame F = make_frame(lds); unsigned char* ws = p.ws(); const float* QF = (const float*)(ws + WS_QF); const float* KF = (const float*)(ws + WS_KF); const float* VF = (const float*)(ws + WS_VF); bf16* H = (bf16*)(ws + WS_H);
    LAS float* sq = (LAS float*)F.lds + F.wave * 768; LAS float* sp = sq + 256;
    const float* sinks = p.in(I_SINKS) + j * NQH; const float* ck = p.in(I_CK); const float* cv = p.in(I_CV); const int lane = F.lane;
    for (int item = F.gw; item < MROWS * NKV; item += F.NGW) {
        const int r = item >> 3, kvh = item & 7; const bool isP = r < MP; const int b = isP ? (r >> 12) : ((r - MP) >> 3), t = isP ? (r & (TP - 1)) : ((r - MP) & (TS - 1));
#pragma unroll
        for (int g = 0; g < 4; ++g) sq[g * 64 + lane] = QF[(size_t)r * DM + (kvh * 4 + g) * HD + lane];
        LDS_WAIT();
        float sc[2][4]; bool valid[2];
#pragma unroll
        for (int s2 = 0; s2 < 2; ++s2) { const int slot = lane + 64 * s2; const float* kp;
            if (isP) { const int pos = t - (WIN - 1) + slot; valid[s2] = pos >= 0; kp = KF + (size_t)(b * TP + (pos < 0 ? 0 : pos)) * KVW + kvh * HD; }
            else { const int a = t + 1 + slot; valid[s2] = true; kp = (a < WIN) ? (ck + ((size_t)(b * WIN + a) * NKV + kvh) * HD) : (KF + (size_t)(MP + b * TS + (a - WIN)) * KVW + kvh * HD); }
#pragma unroll
            for (int g = 0; g < 4; ++g) sc[s2][g] = 0.f;
#pragma unroll 2
            for (int d4 = 0; d4 < 16; ++d4) { const f32x4 k4 = *(const f32x4*)(kp + 4 * d4);
#pragma unroll
                for (int g = 0; g < 4; ++g) { const f32x4 q4 = *(const LAS f32x4*)(sq + g * 64 + 4 * d4); sc[s2][g] += (q4.x * k4.x + q4.y * k4.y) + (q4.z * k4.z + q4.w * k4.w); } } }
#pragma unroll
        for (int g = 0; g < 4; ++g) { const float sk_ = sinks[kvh * 4 + g]; const float s0 = valid[0] ? sc[0][g] * 0.125f : -1e30f, s1 = valid[1] ? sc[1][g] * 0.125f : -1e30f;
            const float m = fmaxf(wave_max(fmaxf(s0, s1)), sk_); const float p0 = valid[0] ? expf(s0 - m) : 0.f, p1 = valid[1] ? expf(s1 - m) : 0.f;
            const float inv = 1.0f / (wave_sum(p0 + p1) + expf(sk_ - m)); sp[g * 128 + lane] = p0 * inv; sp[g * 128 + 64 + lane] = p1 * inv; }
        LDS_WAIT();
        float acc[4] = {0.f, 0.f, 0.f, 0.f};
        for (int slot = 0; slot < WIN; ++slot) { const float* vp;
            if (isP) { const int pos = t - (WIN - 1) + slot; if (pos < 0) continue; vp = VF + (size_t)(b * TP + pos) * KVW + kvh * HD; }
            else { const int a = t + 1 + slot; vp = (a < WIN) ? (cv + ((size_t)(b * WIN + a) * NKV + kvh) * HD) : (VF + (size_t)(MP + b * TS + (a - WIN)) * KVW + kvh * HD); }
            const float vv = vp[lane];
#pragma unroll
            for (int g = 0; g < 4; ++g) acc[g] += sp[g * 128 + slot] * vv; }
#pragma unroll
        for (int g = 0; g < 4; ++g) H[(size_t)r * DM + (kvh * 4 + g) * HD + lane] = (bf16)(pg8::cvt_pk_bf16(acc[g], 0.f) & 0xffffu);
        LDS_WAIT();
    }
}

constexpr int N_PHASES = 1 + 2 * 7 + 2 * 8;
#ifndef ONLY
#define ONLY 0
#endif
#ifndef MASK
#define MASK 0
#endif
#define SEL(k) ((ONLY == 0 && MASK == 0) || ONLY == (k) || ((MASK >> (k)) & 1))
__device__ __forceinline__ void gphase_hproj(LAS unsigned char* lds, int l) {
    const Args p = get_args(); unsigned char* ws = p.ws(); int tid = threadIdx.x; asm volatile("" : "+v"(tid));
    pg8::Gemm g{(const bf16*)(ws + WS_H), (const bf16*)(ws + WS_WH) + (size_t)l * 8192 * 2048, MROWS, 8192, DM}; pg8::StaticOrder S; S.init(MROWS, 8192, (int)gridDim.x, (int)blockIdx.x);
    pg8::EpiHproj E{(bf16*)(ws + WS_Q), (bf16*)(ws + WS_KK), (float*)(ws + WS_LF), (const float*)(ws + WS_LB) + l * DM};
    pg8::gemm_phase<pg8::EpiHproj, pg8::StaticOrder, true, true>(lds, g, S, E, tid);
}
__device__ __forceinline__ void gphase_qkv(LAS unsigned char* lds, int j) {
    const Args p = get_args(); unsigned char* ws = p.ws(); int tid = threadIdx.x; asm volatile("" : "+v"(tid));
    const int N = (j == 0) ? 3072 : 2048; pg8::Gemm g{(const bf16*)(ws + WS_H), (const bf16*)(ws + (j == 0 ? WS_WQKV0 : WS_WQ1)), MROWS, N, DM}; pg8::StaticOrder S; S.init(MROWS, N, (int)gridDim.x, (int)blockIdx.x);
    pg8::EpiRaw E{(float*)(ws + WS_RAW), N};
    pg8::gemm_phase<pg8::EpiRaw, pg8::StaticOrder, true, true>(lds, g, S, E, tid);
}
__device__ __forceinline__ void gphase_wo(LAS unsigned char* lds, int l) {
    const Args p = get_args(); unsigned char* ws = p.ws(); int tid = threadIdx.x; asm volatile("" : "+v"(tid));
    const bf16* Bt = (l < 2) ? (const bf16*)(ws + WS_WOH) + (size_t)l * DM * DM : (const bf16*)(ws + WS_WOA) + (size_t)(l - 2) * DM * DM;
    pg8::Gemm g{(const bf16*)(ws + WS_H), Bt, MROWS, DM, DM}; pg8::StaticOrder S; S.init(MROWS, DM, (int)gridDim.x, (int)blockIdx.x); pg8::EpiResid E{p.out() + O_Y, DM};
    pg8::gemm_phase<pg8::EpiResid, pg8::StaticOrder, true, true>(lds, g, S, E, tid);
}
__device__ __forceinline__ void gphase_ffn1(LAS unsigned char* lds, int l) {
    const Args p = get_args(); unsigned char* ws = p.ws(); int tid = threadIdx.x; asm volatile("" : "+v"(tid));
    pg8::Gemm g{(const bf16*)(ws + WS_H), (const bf16*)(ws + WS_WGU) + (size_t)l * 2 * DFF * DM, MROWS, 2 * DFF, DM}; pg8::StaticOrder S; S.init(MROWS, 2 * DFF, (int)gridDim.x, (int)blockIdx.x); pg8::EpiFfn1 E{(bf16*)(ws + WS_ACT), DFF};
    pg8::gemm_phase<pg8::EpiFfn1, pg8::StaticOrder, true, true>(lds, g, S, E, tid);
}
__device__ __forceinline__ void gphase_ffn2(LAS unsigned char* lds, int l) {
    const Args p = get_args(); unsigned char* ws = p.ws(); int tid = threadIdx.x; asm volatile("" : "+v"(tid));
    pg8::Gemm g{(const bf16*)(ws + WS_ACT), (const bf16*)(ws + WS_WD) + (size_t)l * DM * DFF, MROWS, DM, DFF}; pg8::StaticOrder S; S.init(MROWS, DM, (int)gridDim.x, (int)blockIdx.x); pg8::EpiResid E{p.out() + O_Y, DM};
    pg8::gemm_phase<pg8::EpiResid, pg8::StaticOrder, true, true>(lds, g, S, E, tid);
}
#ifndef V1_SPLIT
#define V1_SPLIT 1
#endif
#if V1_SPLIT
__global__ void __launch_bounds__(NTHREADS, 2) k_gla(Params prm, int l) { extern __shared__ __attribute__((aligned(16))) unsigned char lds_raw[]; (void)prm; phase_gla_simple((LAS unsigned char*)lds_raw, l); }
__global__ void __launch_bounds__(NTHREADS, 2) k_attn(Params prm, int j) { extern __shared__ __attribute__((aligned(16))) unsigned char lds_raw[]; (void)prm; phase_attn_simple((LAS unsigned char*)lds_raw, j); }
#endif
__global__ void __launch_bounds__(NTHREADS, 2) fwd(Params prm) {
    extern __shared__ __attribute__((aligned(16))) unsigned char lds_raw[];
    LAS unsigned char* lds = (LAS unsigned char*)lds_raw;
    const int lo = prm.lo, hi = prm.hi;
    for (int u = threadIdx.x; u < (LDS_BYTES - LDSCTL_OFF) / 4; u += NTHREADS) ((LAS unsigned*)(lds + LDSCTL_OFF))[u] = 0u;
    __syncthreads();
    XcdBarrier bar; bar.bar = (unsigned*)(prm.ws + WS_CTL) + CW_BAR; bar.x = 0; bar.st = nullptr;
    if (hi - lo > 1) bar = xcd_barrier_post((unsigned*)(prm.ws + WS_CTL) + CW_BAR, (volatile LAS unsigned*)(lds + MISC_OFF) + 8);
    int ph = 0;
#define PH_BEGIN if (ph >= lo && ph < hi) {
#define PH_END   if (ph + 1 < hi) xcd_barrier(bar); } ++ph;
    PH_BEGIN if (SEL(1)) phase_prologue(lds); PH_END
    for (int l = 0; l < 4; ++l) {
        if (l < 2) {
            PH_BEGIN if (SEL(2)) phase_norm(lds); PH_END
            PH_BEGIN if (SEL(6)) gphase_hproj(lds, l); PH_END
            PH_BEGIN if (SEL(3) && !V1_SPLIT) phase_gla_simple(lds, l); PH_END
        } else {
            PH_BEGIN if (SEL(2)) phase_norm(lds); PH_END
            PH_BEGIN if (SEL(7)) gphase_qkv(lds, l - 2); PH_END
            PH_BEGIN if (SEL(4)) phase_post(lds, l - 2); PH_END
            PH_BEGIN if (SEL(5) && !V1_SPLIT) phase_attn_simple(lds, l - 2); PH_END
        }
        PH_BEGIN if (SEL(8)) gphase_wo(lds, l); PH_END
        PH_BEGIN if (SEL(2)) phase_norm(lds); PH_END
        PH_BEGIN if (SEL(9)) gphase_ffn1(lds, l); PH_END
        PH_BEGIN if (SEL(10)) gphase_ffn2(lds, l); PH_END
    }
#undef PH_BEGIN
#undef PH_END
}

extern "C" void kernel_launch(void* const* d_in, const int* in_sizes, int n_in, void* d_out, int out_size, void* d_ws, size_t ws_size, hipStream_t stream) {
    static int ready = 0;
    if (ready == 0) {
        if (n_in != 26 || (size_t)out_size != O_END || ws_size < WS_END) { fprintf(stderr, "kernel_launch: unexpected shapes (n_in %d, out %d, ws %zu; need ws >= %zu)\n", n_in, out_size, ws_size, (size_t)WS_END); ready = -1; return; }
#if V1_SPLIT
        (void)hipFuncSetAttribute((const void*)k_gla, hipFuncAttributeMaxDynamicSharedMemorySize, LDS_BYTES); (void)hipFuncSetAttribute((const void*)k_attn, hipFuncAttributeMaxDynamicSharedMemorySize, LDS_BYTES);
#endif
        if (hipFuncSetAttribute((const void*)fwd, hipFuncAttributeMaxDynamicSharedMemorySize, LDS_BYTES) != hipSuccess) { fprintf(stderr, "kernel_launch: hipFuncSetAttribute failed\n"); ready = -1; return; }
        ready = 1;
    }
    if (ready < 0) return;
    (void)in_sizes;
    if (hipMemsetAsync((char*)d_ws + WS_CTL, 0, CTL_ZERO_BYTES, stream) != hipSuccess) return;
    Params p{};
    for (int i = 0; i < 26; ++i) p.in[i] = (const float*)d_in[i];
    p.out = (float*)d_out; p.ws = (unsigned char*)d_ws;
    for (int ph = 0; ph < N_PHASES; ++ph) { p.lo = ph; p.hi = ph + 1;
#if V1_SPLIT
        if (ph == 3 || ph == 10) { hipLaunchKernelGGL(k_gla, dim3(256), dim3(NTHREADS), LDS_BYTES, stream, p, ph == 3 ? 0 : 1); continue; }
        if (ph == 18 || ph == 26) { hipLaunchKernelGGL(k_attn, dim3(256), dim3(NTHREADS), LDS_BYTES, stream, p, ph == 18 ? 0 : 1); continue; }
#endif
        hipLaunchKernelGGL(fwd, dim3(256), dim3(NTHREADS), LDS_BYTES, stream, p); }
}
```

```cpp
#include <hip/hip_runtime.h>
#include <cstdio>
#include <cstdint>

constexpr int NWAVES = 8, NTHREADS = 512;
constexpr int DM = 2048, DFF = 5632, TP = 4096, NBP = 2, NBS = 32, TS = 8;
constexpr int MP = NBP * TP  , MS = NBS * TS  , MROWS = MP + MS  ;
constexpr int NH = 16, DK = 128;
constexpr int NQH = 32, NKV = 8, HD = 64, KVW = NKV * HD  , WIN = 128;
constexpr int NPOS = TP + TS;
constexpr float RMS_EPS = 1e-6f;
constexpr size_t O_Y = 0, O_STP = (size_t)MROWS * DM, O_STS = O_STP + (size_t)2 * NBP * NH * DK * DK, O_KWP = O_STS + (size_t)2 * NBS * NH * DK * DK,
                 O_VWP = O_KWP + (size_t)NBP * WIN * KVW, O_KWS = O_VWP + (size_t)NBP * WIN * KVW, O_VWS = O_KWS + (size_t)NBS * WIN * KVW, O_END = O_VWS + (size_t)NBS * WIN * KVW;
static_assert(O_END == 39583744, "output size");
constexpr size_t MiB = 1u << 20;
constexpr size_t WS_CTL = 0, CTL_ZERO_BYTES = 1 * MiB;
constexpr size_t WS_LB = 1 * MiB, WS_ROPE = 1 * MiB + 65536;
constexpr size_t WS_WH = 4 * MiB, WS_WOH = WS_WH + 64 * MiB, WS_WQKV0 = WS_WOH + 16 * MiB, WS_WQ1 = WS_WQKV0 + 12 * MiB, WS_WOA = WS_WQ1 + 8 * MiB, WS_WGU = WS_WOA + 16 * MiB, WS_WD = WS_WGU + 176 * MiB;
constexpr size_t WS_H = WS_WD + 88 * MiB;
constexpr size_t WS_P = WS_H + 33 * MiB;
constexpr size_t WS_Q = WS_P, WS_KK = WS_P + 33 * MiB, WS_V = WS_P + 66 * MiB, WS_GT = WS_P + 99 * MiB, WS_LF = WS_P + 132 * MiB;
constexpr size_t WS_ACT = WS_P;
constexpr size_t WS_RAW = WS_P, WS_QF = WS_P + 99 * MiB, WS_KF = WS_P + 165 * MiB, WS_VF = WS_KF + (size_t)MROWS * KVW * 4;
constexpr size_t WS_OPS = WS_P + 198 * MiB, WS_SLOC = WS_OPS + 108 * MiB, WS_DSEG = WS_SLOC + 16 * MiB;
constexpr size_t WS_KC = WS_OPS, WS_VC = WS_OPS + 8 * MiB, WS_QC = WS_OPS + 16 * MiB;
constexpr size_t WS_SLAB = WS_DSEG + 1 * MiB;
constexpr size_t WS_XB = WS_SLAB + 64 * MiB;
constexpr size_t WS_RS = WS_XB + 33 * MiB;
constexpr size_t WS_XL = WS_RS + 1 * MiB;
constexpr size_t WS_END = WS_XL + 33 * MiB;
static_assert(WS_KK - WS_Q == 33 * MiB && WS_V - WS_Q == 66 * MiB && WS_GT - WS_Q == 99 * MiB, "EpiHproj addresses Q|KK|V|GT by type * 33 MiB");
static_assert(WS_ROPE + (size_t)NPOS * 32 * 8 <= WS_WH && WS_VF + (size_t)MROWS * KVW * 4 <= WS_OPS && (size_t)4096 * 27648 <= 108 * MiB && WS_ACT + (size_t)MROWS * DFF * 2 <= WS_KF, "ws map");
constexpr int CW_BAR = 4096, CW_TMO2 = 8000, CW_CNT = 8192, CW_Q = 12288;
constexpr int LDS_BYTES = 147456, LDSCTL_OFF = LDS_BYTES - 1024, MISC_OFF = LDSCTL_OFF + 320;

__device__ __forceinline__ float shx(float v, int k, int lane) { return __int_as_float(__builtin_amdgcn_ds_bpermute((lane ^ k) << 2, __float_as_int(v))); }
namespace pg8 {
#define PG8_LAS __attribute__((address_space(3)))
typedef unsigned short bf16_t;
typedef short bf16x8 __attribute__((ext_vector_type(8)));
typedef float f32x4 __attribute__((ext_vector_type(4)));
typedef unsigned u32x4 __attribute__((ext_vector_type(4)));
constexpr int BM = 256, BK = 64, HALF = 128, HTB = HALF * BK * 2  , STAGE_BYTES = 8 * HTB, NXCD = 8, WGM = 8;

__host__ __device__ __forceinline__ int lds_byte(int r, int c) { const int st = (r >> 4) * 2 + (c >> 5), rr = r & 15, cc = c & 31, ob = rr * 64 + cc * 2; return st * 1024 + (ob ^ (((ob >> 9) & 1) << 5)); }
__host__ __device__ __forceinline__ void stage_rc(int b, int& R, int& C) { const int st = b / 1024, sb = b % 1024, swz = sb ^ (((sb >> 9) & 1) << 5); R = (st >> 1) * 16 + swz / 64; C = (st & 1) * 32 + (swz % 64) / 2; }
__host__ __device__ __forceinline__ int perm32(int rho) { const int n = rho >> 4, i = rho & 15; return 8 * (i >> 2) + 4 * n + (i & 3); }

struct Unit { int pm, pn, k0, nt, ks; };
struct Gemm { const bf16_t* A; const bf16_t* Bt; int M, N, K; };

struct StaticOrder {
    int nM, nN, nwg, G, c, ntK;
    __host__ __device__ __forceinline__ void init(int M, int N, int K, int G_, int c_) { nM = M / BM; nN = N / BM; nwg = nM * nN; G = G_; c = c_; ntK = K / BK; }
    __host__ __device__ __forceinline__ bool next(int i, Unit& u) const {
        const int L = i * G + c; if (L >= nwg) return false;
        int wgid = (int)L; { const int q = nwg / NXCD, r = nwg % NXCD, xcd = wgid % NXCD, off = wgid / NXCD; wgid = (xcd < r ? xcd * (q + 1) : r * (q + 1) + (xcd - r) * q) + off; }
        const int nig = WGM * nN, gid = wgid / nig, fm = gid * WGM, gsz = (nM - fm) < WGM ? (nM - fm) : WGM;
        u.pm = fm + ((wgid % nig) % gsz); u.pn = (wgid % nig) / gsz; u.k0 = 0; u.nt = ntK; u.ks = -1; return true;
    }
    const unsigned* cnt; unsigned need; unsigned* tmo;
    __device__ __forceinline__ void a_ready(const Unit& u) const {
        if (u.pm == 32 && need != 0u) {
            if (__builtin_amdgcn_readfirstlane((int)threadIdx.x >> 6) == 0) {
                unsigned polls = 0;
                while ((unsigned)__builtin_amdgcn_readfirstlane(__hip_atomic_load(cnt, __ATOMIC_RELAXED, __HIP_MEMORY_SCOPE_AGENT)) < need) {
                    if (++polls > (1u << 20)) { if (threadIdx.x == 0) __hip_atomic_store(tmo, 1u, __ATOMIC_RELAXED, __HIP_MEMORY_SCOPE_AGENT); break; }
                    __builtin_amdgcn_s_sleep(2); }
                __builtin_amdgcn_fence(__ATOMIC_ACQUIRE, "agent");
                asm volatile("s_waitcnt vmcnt(0)" ::: "memory");
            }
            asm volatile("" ::: "memory"); __builtin_amdgcn_s_barrier(); asm volatile("" ::: "memory");
        }
    }
    __device__ __forceinline__ void done(const Unit&) const {}
};
struct SplitOrder {
    int nN, nP, nS, nTot, G, c, ntP, ntS, sfirst;
    __host__ __device__ __forceinline__ void init(int N, int K, int KS, int G_, int c_, int sfirst_ = 0) { nN = N / BM; nP = 32 * nN; nS = nN * KS; nTot = nP + nS; ntP = K / BK; ntS = ntP / KS; G = G_; c = c_; sfirst = sfirst_; }
    __host__ __device__ __forceinline__ bool next(int i, Unit& u) const {
        const int L = i * G + c; if (L >= nTot) return false;
        const bool isP = sfirst ? (L >= nS) : (L < nP); const int Lp = isP ? (sfirst ? L - nS : L) : 0, s = isP ? 0 : (sfirst ? L : L - nP);
        const int q = nP / NXCD, wgid = (Lp % NXCD) * q + Lp / NXCD, nig = WGM * nN;
        const int pmP = (wgid / nig) * WGM + ((wgid % nig) % WGM), pnP = (wgid % nig) / WGM, ksS = s / nN;
        u.pm = isP ? pmP : 32; u.pn = isP ? pnP : s - ksS * nN; u.ks = isP ? -1 : ksS; u.k0 = isP ? 0 : ksS * ntS * BK; u.nt = isP ? ntP : ntS;
        return true;
    }
    const unsigned* cnt; unsigned need; unsigned* tmo;
    __device__ __forceinline__ void a_ready(const Unit& u) const {
        if (u.pm == 32 && need != 0u) {
            if (__builtin_amdgcn_readfirstlane((int)threadIdx.x >> 6) == 0) {
                unsigned polls = 0;
                while ((unsigned)__builtin_amdgcn_readfirstlane(__hip_atomic_load(cnt, __ATOMIC_RELAXED, __HIP_MEMORY_SCOPE_AGENT)) < need) {
                    if (++polls > (1u << 20)) { if (threadIdx.x == 0) __hip_atomic_store(tmo, 1u, __ATOMIC_RELAXED, __HIP_MEMORY_SCOPE_AGENT); break; }
                    __builtin_amdgcn_s_sleep(2); }
                __builtin_amdgcn_fence(__ATOMIC_ACQUIRE, "agent");
                asm volatile("s_waitcnt vmcnt(0)" ::: "memory");
            }
            asm volatile("" ::: "memory"); __builtin_amdgcn_s_barrier(); asm volatile("" ::: "memory");
        }
    }
    __device__ __forceinline__ void done(const Unit&) const {}
};

#define PG8_GAS __attribute__((address_space(1)))
__device__ __forceinline__ unsigned cvt_pk_bf16(float lo, float hi) { unsigned r; asm volatile("v_cvt_pk_bf16_f32 %0, %1, %2" : "=v"(r) : "v"(lo), "v"(hi)); return r; }
__device__ __forceinline__ float silu_f(float a) { return a * __builtin_amdgcn_rcpf(1.0f + __expf(-a)); }
__device__ __forceinline__ u32x4 pack8(const f32x4 v0, const f32x4 v1) { u32x4 w; w.x = cvt_pk_bf16(v0[0], v0[1]); w.y = cvt_pk_bf16(v0[2], v0[3]); w.z = cvt_pk_bf16(v1[0], v1[1]); w.w = cvt_pk_bf16(v1[2], v1[3]); return w; }

struct NoState {};
struct RsState { float r[2]; };
__device__ __forceinline__ void rs_request(RsState& st, const float* RS, const Unit& u, int wr, int fr, int fq) { const int l = fr + 16 * fq; st.r[0] = ((const PG8_GAS float*)RS)[u.pm * BM + wr * 64 + l]; st.r[1] = ((const PG8_GAS float*)RS)[u.pm * BM + HALF + wr * 64 + l]; }
__device__ __forceinline__ float rstd_get(const RsState& st, int ai, int m, int fr) { const float v = __int_as_float(__builtin_amdgcn_ds_bpermute((16 * m + fr) << 2, __float_as_int(st.r[ai]))); return __builtin_amdgcn_rsqf(v * (1.0f / 2048.0f) + 1e-6f); }
struct EpiResid {
    static constexpr bool PERM = true, AFTER_DRAIN = false;
    typedef NoState State;
    const float* Xin32; float* Yout32; int ldc; float* slab; bf16_t* XB; bf16_t* XL; float* RS;
    __device__ __forceinline__ void init(f32x4 (&acc)[2][2][4][2], State&, const Unit& u, int wr, int wc, int fr, int fq) const {
        if (u.ks < 0) { const size_t off0 = (size_t)(u.pm * BM + wr * 64 + fr) * ldc + u.pn * BM + wc * 32 + 8 * fq;
            if (Xin32) {
#pragma unroll
                for (int a = 0; a < 2; ++a)
#pragma unroll
                    for (int b = 0; b < 2; ++b)
#pragma unroll
                        for (int m = 0; m < 4; ++m)
#pragma unroll
                            for (int n = 0; n < 2; ++n) acc[a][b][m][n] = *(const PG8_GAS f32x4*)((const PG8_GAS float*)Xin32 + off0 + (size_t)(a * HALF + m * 16) * ldc + b * HALF + 4 * n);
            } else {
#pragma unroll
                for (int a = 0; a < 2; ++a)
#pragma unroll
                    for (int b = 0; b < 2; ++b)
#pragma unroll
                        for (int m = 0; m < 4; ++m) { const size_t o = off0 + (size_t)(a * HALF + m * 16) * ldc + b * HALF;
                            const u32x4 h = *(const PG8_GAS u32x4*)((const PG8_GAS bf16_t*)XB + o), l = *(const PG8_GAS u32x4*)((const PG8_GAS bf16_t*)XL + o);
#pragma unroll
                            for (int k = 0; k < 4; ++k) { const float h0 = __uint_as_float(h[k] << 16), h1 = __uint_as_float(h[k] & 0xffff0000u), l0 = __uint_as_float(l[k] << 16), l1 = __uint_as_float(l[k] & 0xffff0000u);
                                acc[a][b][m][k >> 1][2 * (k & 1)] = h0 + l0; acc[a][b][m][k >> 1][2 * (k & 1) + 1] = h1 + l1; } }
            }
        } else {
#pragma unroll
            for (int a = 0; a < 2; ++a)
#pragma unroll
                for (int b = 0; b < 2; ++b)
#pragma unroll
                    for (int m = 0; m < 4; ++m)
#pragma unroll
                        for (int n = 0; n < 2; ++n) acc[a][b][m][n] = (f32x4){0.f, 0.f, 0.f, 0.f}; } }
    __device__ __forceinline__ void operator()(const f32x4 (&acc)[2][2][4][2], const State& st, const Unit& u, int wr, int wc, int fr_, int fq_) const {
        int fr = fr_, fq = fq_; asm volatile("" : "+v"(fr), "+v"(fq));
        const int row0 = u.pm * BM + wr * 64 + fr, col0 = u.pn * BM + wc * 32 + 8 * fq;
        if (u.ks >= 0) {
#pragma unroll
            for (int ai = 0; ai < 2; ++ai)
#pragma unroll
                for (int m = 0; m < 4; ++m) { PG8_GAS float* rowp = (PG8_GAS float*)slab + ((size_t)u.ks * BM + (wr * 64 + fr + ai * HALF + m * 16)) * ldc + col0;
#pragma unroll
                    for (int bj = 0; bj < 2; ++bj) { *(PG8_GAS f32x4*)(rowp + bj * HALF) = acc[ai][bj][m][0]; *(PG8_GAS f32x4*)(rowp + bj * HALF + 4) = acc[ai][bj][m][1]; } }
            return; }
        if (Yout32) {
#pragma unroll
            for (int ai = 0; ai < 2; ++ai)
#pragma unroll
                for (int m = 0; m < 4; ++m) { PG8_GAS float* rowp = (PG8_GAS float*)Yout32 + (size_t)(row0 + ai * HALF + m * 16) * ldc + col0;
#pragma unroll
                    for (int bj = 0; bj < 2; ++bj) { *(PG8_GAS f32x4*)(rowp + bj * HALF) = acc[ai][bj][m][0]; *(PG8_GAS f32x4*)(rowp + bj * HALF + 4) = acc[ai][bj][m][1]; } }
            return; }
#pragma unroll
        for (int ai = 0; ai < 2; ++ai)
#pragma unroll
            for (int m = 0; m < 4; ++m) { const size_t o = (size_t)(row0 + ai * HALF + m * 16) * ldc + col0; float ss = 0.f;
#pragma unroll
                for (int bj = 0; bj < 2; ++bj) { const f32x4 v0 = acc[ai][bj][m][0], v1 = acc[ai][bj][m][1];
                    ss += ((v0[0] * v0[0] + v0[1] * v0[1]) + (v0[2] * v0[2] + v0[3] * v0[3])) + ((v1[0] * v1[0] + v1[1] * v1[1]) + (v1[2] * v1[2] + v1[3] * v1[3]));
                    const u32x4 h = pack8(v0, v1); f32x4 r0, r1;
#pragma unroll
                    for (int k = 0; k < 2; ++k) { r0[2 * k] = v0[2 * k] - __uint_as_float(h[k] << 16); r0[2 * k + 1] = v0[2 * k + 1] - __uint_as_float(h[k] & 0xffff0000u);
                        r1[2 * k] = v1[2 * k] - __uint_as_float(h[2 + k] << 16); r1[2 * k + 1] = v1[2 * k + 1] - __uint_as_float(h[2 + k] & 0xffff0000u); }
                    *(PG8_GAS u32x4*)((PG8_GAS bf16_t*)XB + o + bj * HALF) = h; *(PG8_GAS u32x4*)((PG8_GAS bf16_t*)XL + o + bj * HALF) = pack8(r0, r1); }
                ss += shx(ss, 16, fr + 16 * fq); ss += shx(ss, 32, fr + 16 * fq);
                if (fq == 0) atomicAdd(RS + row0 + ai * HALF + m * 16, ss);
                asm volatile("" ::: "memory"); }
    }
};
struct EpiRaw {
    static constexpr bool PERM = true, AFTER_DRAIN = false;
    typedef RsState State;
    __device__ __forceinline__ void init(f32x4 (&acc)[2][2][4][2], State& st, const Unit& u, int wr, int wc, int fr, int fq) const { rs_request(st, RS, u, wr, fr, fq); (void)wc;
#pragma unroll
        for (int a = 0; a < 2; ++a)
#pragma unroll
            for (int b = 0; b < 2; ++b)
#pragma unroll
                for (int m = 0; m < 4; ++m)
#pragma unroll
                    for (int n = 0; n < 2; ++n) acc[a][b][m][n] = (f32x4){0.f, 0.f, 0.f, 0.f}; }
    bf16_t* C; int ldc; float* slab; const float* RS;
    __device__ __forceinline__ void operator()(const f32x4 (&acc)[2][2][4][2], const State& st, const Unit& u, int wr, int wc, int fr_, int fq_) const {
        int fr = fr_, fq = fq_; asm volatile("" : "+v"(fr), "+v"(fq));
        const int row0 = u.pm * BM + wr * 64 + fr, col0 = u.pn * BM + wc * 32 + 8 * fq;
        if (u.ks >= 0) {
#pragma unroll
            for (int ai = 0; ai < 2; ++ai)
#pragma unroll
                for (int m = 0; m < 4; ++m) { PG8_GAS float* rowp = (PG8_GAS float*)slab + ((size_t)u.ks * BM + (wr * 64 + fr + ai * HALF + m * 16)) * ldc + col0; const float rstd = rstd_get(st, ai, m, fr);
#pragma unroll
                    for (int bj = 0; bj < 2; ++bj) { *(PG8_GAS f32x4*)(rowp + bj * HALF) = acc[ai][bj][m][0] * rstd; *(PG8_GAS f32x4*)(rowp + bj * HALF + 4) = acc[ai][bj][m][1] * rstd; } }
            return; }
#pragma unroll
        for (int ai = 0; ai < 2; ++ai)
#pragma unroll
            for (int m = 0; m < 4; ++m) { PG8_GAS bf16_t* rowp = (PG8_GAS bf16_t*)C + (size_t)(row0 + ai * HALF + m * 16) * ldc + col0; const float rstd = rstd_get(st, ai, m, fr);
#pragma unroll
                for (int bj = 0; bj < 2; ++bj) *(PG8_GAS u32x4*)(rowp + bj * HALF) = pack8(acc[ai][bj][m][0] * rstd, acc[ai][bj][m][1] * rstd); }
    }
};
struct EpiFfn1 {
    static constexpr bool PERM = true, AFTER_DRAIN = false;
    typedef RsState State;
    __device__ __forceinline__ void init(f32x4 (&acc)[2][2][4][2], State& st, const Unit& u, int wr, int wc, int fr, int fq) const { rs_request(st, RS, u, wr, fr, fq); (void)wc;
#pragma unroll
        for (int a = 0; a < 2; ++a)
#pragma unroll
            for (int b = 0; b < 2; ++b)
#pragma unroll
                for (int m = 0; m < 4; ++m)
#pragma unroll
                    for (int n = 0; n < 2; ++n) acc[a][b][m][n] = (f32x4){0.f, 0.f, 0.f, 0.f}; }
    bf16_t* O; int ldc; const float* RS;
    __device__ __forceinline__ void operator()(const f32x4 (&acc)[2][2][4][2], const State& st, const Unit& u, int wr, int wc, int fr_, int fq_) const {
        int fr = fr_, fq = fq_; asm volatile("" : "+v"(fr), "+v"(fq));
        const int row0 = u.pm * BM + wr * 64 + fr, col0 = u.pn * HALF + wc * 32 + 8 * fq;
#pragma unroll
        for (int ai = 0; ai < 2; ++ai)
#pragma unroll
            for (int m = 0; m < 4; ++m) { PG8_GAS bf16_t* rowp = (PG8_GAS bf16_t*)O + (size_t)(row0 + ai * HALF + m * 16) * ldc + col0;
                f32x4 v0, v1; const float rstd = rstd_get(st, ai, m, fr);
#pragma unroll
                for (int e = 0; e < 4; ++e) { v0[e] = silu_f(acc[ai][0][m][0][e] * rstd) * (acc[ai][1][m][0][e] * rstd); v1[e] = silu_f(acc[ai][0][m][1][e] * rstd) * (acc[ai][1][m][1][e] * rstd); }
                *(PG8_GAS u32x4*)rowp = pack8(v0, v1); }
    }
};
struct EpiHproj {
    static constexpr bool PERM = true, AFTER_DRAIN = false;
    typedef RsState State;
    __device__ __forceinline__ void init(f32x4 (&acc)[2][2][4][2], State& st, const Unit& u, int wr, int wc, int fr, int fq) const { rs_request(st, (const float*)(ws + WS_RS) + MROWS, u, wr, fr, fq); (void)wc;
#pragma unroll
        for (int a = 0; a < 2; ++a)
#pragma unroll
            for (int b = 0; b < 2; ++b)
#pragma unroll
                for (int m = 0; m < 4; ++m)
#pragma unroll
                    for (int n = 0; n < 2; ++n) acc[a][b][m][n] = (f32x4){0.f, 0.f, 0.f, 0.f}; }
    unsigned char* ws; int l;
    __device__ __forceinline__ void operator()(const f32x4 (&acc)[2][2][4][2], const State& st, const Unit& u, int wr, int wc, int fr_, int fq_) const {
        int fr = fr_, fq = fq_; asm volatile("" : "+v"(fr), "+v"(fq));
        bf16_t* const Q = (bf16_t*)(ws + WS_Q); float* const LF = (float*)(ws + WS_LF); const float* const lb = (const float*)(ws + WS_LB) + l * 2048; float* const slab = (float*)(ws + WS_SLAB);
        const int row0 = u.pm * BM + wr * 64 + fr; const int type = u.pn >> 3; const int col0 = (u.pn & 7) * BM + wc * 32 + 8 * fq;
        if (u.ks >= 0) {
#pragma unroll
            for (int ai = 0; ai < 2; ++ai)
#pragma unroll
                for (int m = 0; m < 4; ++m) { const float rstd = rstd_get(st, ai, m, fr); PG8_GAS float* rowp = (PG8_GAS float*)slab + ((size_t)u.ks * BM + (wr * 64 + fr + ai * HALF + m * 16)) * 8192 + u.pn * BM + wc * 32 + 8 * fq;
#pragma unroll
                    for (int bj = 0; bj < 2; ++bj) { *(PG8_GAS f32x4*)(rowp + bj * HALF) = acc[ai][bj][m][0] * rstd; *(PG8_GAS f32x4*)(rowp + bj * HALF + 4) = acc[ai][bj][m][1] * rstd; } }
            return; }
        if (type == 1) {
#pragma unroll
            for (int bj = 0; bj < 2; ++bj) {
                const f32x4 lb0 = *(const PG8_GAS f32x4*)((const PG8_GAS float*)lb + col0 + bj * HALF), lb1 = *(const PG8_GAS f32x4*)((const PG8_GAS float*)lb + col0 + bj * HALF + 4);
#pragma unroll
                for (int ai = 0; ai < 2; ++ai)
#pragma unroll
                    for (int m = 0; m < 4; ++m) { const size_t off = (size_t)(row0 + ai * HALF + m * 16) * 2048 + col0 + bj * HALF; const float rstd = rstd_get(st, ai, m, fr);
#pragma unroll
                        for (int n = 0; n < 2; ++n) { f32x4 lf;
#pragma unroll
                            for (int e = 0; e < 4; ++e) { float z = acc[ai][bj][m][n][e] * rstd; z = fminf(fmaxf(z, -80.f), 80.f); const float ex = __expf(-z), s = __builtin_amdgcn_rcpf(1.0f + ex), l = n ? lb1[e] : lb0[e];
                                const float f = l + (1.0f - l) * s; lf[e] = __logf(fmaxf(f, 1e-30f)); }
                            *(PG8_GAS f32x4*)((PG8_GAS float*)LF + off + 4 * n) = lf; } } }
        } else {
            PG8_GAS bf16_t* dst = (PG8_GAS bf16_t*)Q + (size_t)type * ((size_t)33 << 19);
#pragma unroll
            for (int ai = 0; ai < 2; ++ai)
#pragma unroll
                for (int m = 0; m < 4; ++m) { const size_t off = (size_t)(row0 + ai * HALF + m * 16) * 2048 + col0; const float rstd = rstd_get(st, ai, m, fr);
#pragma unroll
                    for (int bj = 0; bj < 2; ++bj) { f32x4 v0 = acc[ai][bj][m][0] * rstd, v1 = acc[ai][bj][m][1] * rstd;
                        if (type == 0) {
#pragma unroll
                            for (int e = 0; e < 4; ++e) { v0[e] = silu_f(v0[e]) * 0.08838834764831845f; v1[e] = silu_f(v1[e]) * 0.08838834764831845f; } }
                        else if (type == 3) {
#pragma unroll
                            for (int e = 0; e < 4; ++e) { v0[e] = silu_f(v0[e]); v1[e] = silu_f(v1[e]); } }
                        *(PG8_GAS u32x4*)(dst + off + bj * HALF) = pack8(v0, v1); } }
        }
    }
};
template <class Epi, class Sched, bool ALIGN_EPI = false, bool SP2 = false>
__device__ __forceinline__ void gemm_phase(PG8_LAS unsigned char* lds, const Gemm g, const Sched& S, const Epi& E, const int tid) {
    const int wid = __builtin_amdgcn_readfirstlane(tid >> 6), lane = tid & 63, wr = wid >> 2, wc = wid & 3, fr = lane & 15, fq = lane >> 4;
    const int K = g.K;
    unsigned voffA[2], voffB[2];
#pragma unroll
    for (int i = 0; i < 2; ++i) { int R, C; stage_rc(tid * 16 + i * 8192, R, C); const int Rb = Epi::PERM ? ((R & ~31) + perm32(R & 31)) : R;
        voffA[i] = (unsigned)(R * K + C) * 2u; voffB[i] = (unsigned)(Rb * K + C) * 2u; }
    const size_t kstep = (size_t)(BK * 2);
    const size_t hstep = (size_t)HALF * K * 2;
    const size_t tstep = 2 * hstep;
    const unsigned ldsw = (unsigned)wid * 1024u;
    const int aoff = lds_byte(wr * 64 + fr, fq * 8), boff = lds_byte(wc * 32 + fr, fq * 8);
#define PG8_SA(b, h) (((b) * 2 + (h)) * HTB)
#define PG8_SB(b, h) ((4 + (b) * 2 + (h)) * HTB)
#define PG8_STAGE(bufoff, gbase, voff) do { _Pragma("unroll") for (int _i = 0; _i < 2; ++_i) \
        __builtin_amdgcn_global_load_lds((const unsigned*)((const char*)(gbase) + (voff)[_i]), (PG8_LAS unsigned*)(lds + (bufoff) + ldsw + _i * 8192), 16, 0, 0); } while (0)
#define PG8_LDA(dst, b, h) do { _Pragma("unroll") for (int m = 0; m < 4; ++m) _Pragma("unroll") for (int k = 0; k < 2; ++k) dst[m][k] = *(const PG8_LAS bf16x8*)(lds + PG8_SA(b, h) + aoff + m * 2048 + k * 1024); } while (0)
#define PG8_LDB(dst, b, h) do { _Pragma("unroll") for (int n = 0; n < 2; ++n) _Pragma("unroll") for (int k = 0; k < 2; ++k) dst[n][k] = *(const PG8_LAS bf16x8*)(lds + PG8_SB(b, h) + boff + n * 2048 + k * 1024); } while (0)
#define PG8_MMA(ai, bj, At, Bt) do { __builtin_amdgcn_s_setprio(1); _Pragma("unroll") for (int m = 0; m < 4; ++m) _Pragma("unroll") for (int n = 0; n < 2; ++n) _Pragma("unroll") for (int k = 0; k < 2; ++k) \
        acc[ai][bj][m][n] = __builtin_amdgcn_mfma_f32_16x16x32_bf16(Bt[n][k], At[m][k], acc[ai][bj][m][n], 0, 0, 0); __builtin_amdgcn_s_setprio(0); } while (0)
#define PG8_WAIT_V(n) asm volatile("s_waitcnt vmcnt(" #n ")" ::: "memory")
#define PG8_WAIT_L(n) asm volatile("s_waitcnt lgkmcnt(" #n ")" ::: "memory")
#define PG8_BAR __builtin_amdgcn_s_barrier()
#define PG8_SCHED __builtin_amdgcn_sched_barrier(0)
    Unit cur, nxt; int ui = 0;
    if (!S.next(0, cur)) return;
    f32x4 acc[2][2][4][2];
    typename Epi::State est;
    E.init(acc, est, cur, wr, wc, fr, fq);
    bf16x8 At[4][2], B0[2][2], B1[2][2];
    const char* cA = (const char*)g.A + (size_t)cur.pm * tstep + (size_t)cur.k0 * 2; const char* cB = (const char*)g.Bt + (size_t)cur.pn * tstep + (size_t)cur.k0 * 2;
    S.a_ready(cur);
    if constexpr (SP2) {
        PG8_STAGE(PG8_SB(0, 0), cB, voffB); PG8_STAGE(PG8_SB(0, 1), cB + hstep, voffB); PG8_STAGE(PG8_SA(0, 0), cA, voffA); PG8_STAGE(PG8_SA(0, 1), cA + hstep, voffA);
        if (wr == 1) PG8_BAR;
        PG8_WAIT_V(2); PG8_BAR;
        PG8_STAGE(PG8_SB(1, 0), cB + kstep, voffB); PG8_STAGE(PG8_SA(1, 0), cA + kstep, voffA); PG8_STAGE(PG8_SB(1, 1), cB + hstep + kstep, voffB);
        PG8_WAIT_V(6); PG8_BAR;
    } else {
        PG8_STAGE(PG8_SB(0, 0), cB, voffB); PG8_STAGE(PG8_SA(0, 0), cA, voffA); PG8_STAGE(PG8_SB(0, 1), cB + hstep, voffB); PG8_STAGE(PG8_SA(0, 1), cA + hstep, voffA);
        if (wr == 1) PG8_BAR;
        PG8_WAIT_V(4); PG8_BAR;
        PG8_STAGE(PG8_SB(1, 0), cB + kstep, voffB); PG8_STAGE(PG8_SA(1, 0), cA + kstep, voffA); PG8_STAGE(PG8_SB(1, 1), cB + hstep + kstep, voffB);
        PG8_WAIT_V(6); PG8_BAR;
    }
    for (;;) {
        const bool has_next = S.next(ui + 1, nxt);
        const char* nA = has_next ? (const char*)g.A + (size_t)nxt.pm * tstep + (size_t)nxt.k0 * 2 : cA; const char* nB = has_next ? (const char*)g.Bt + (size_t)nxt.pn * tstep + (size_t)nxt.k0 * 2 : cB;
        const int nt = cur.nt;
        for (int t = 0; t < nt; t += 2) {
            const bool last = (t == nt - 2);
            const char* a1 = cA + (size_t)(t + 1) * kstep;
            const char* a2 = last ? nA : cA + (size_t)(t + 2) * kstep; const char* b2 = last ? nB : cB + (size_t)(t + 2) * kstep;
            const char* a3 = a2 + kstep; const char* b3 = b2 + kstep;
            if (last && has_next) S.a_ready(nxt);
            if constexpr (SP2) {
            PG8_LDB(B0, 0, 0); PG8_LDB(B1, 0, 1); PG8_SCHED; PG8_LDA(At, 0, 0); PG8_STAGE(PG8_SA(1, 1), a1 + hstep, voffA);
            PG8_WAIT_V(8); PG8_WAIT_L(0); PG8_BAR; PG8_MMA(0, 0, At, B0); PG8_MMA(0, 1, At, B1); PG8_BAR; PG8_SCHED;
            PG8_LDA(At, 0, 1); PG8_STAGE(PG8_SB(0, 0), b2, voffB); PG8_STAGE(PG8_SB(0, 1), b2 + hstep, voffB); PG8_STAGE(PG8_SA(0, 0), a2, voffA);
            PG8_WAIT_V(8); PG8_WAIT_L(0); PG8_BAR; PG8_MMA(1, 0, At, B0); PG8_MMA(1, 1, At, B1); PG8_BAR; PG8_SCHED;
            PG8_LDB(B0, 1, 0); PG8_LDB(B1, 1, 1); PG8_SCHED; PG8_LDA(At, 1, 0); PG8_STAGE(PG8_SA(0, 1), a2 + hstep, voffA);
            PG8_WAIT_V(8); PG8_WAIT_L(0); PG8_BAR; PG8_MMA(0, 0, At, B0); PG8_MMA(0, 1, At, B1); PG8_BAR; PG8_SCHED;
            PG8_LDA(At, 1, 1); PG8_STAGE(PG8_SB(1, 0), b3, voffB); PG8_STAGE(PG8_SB(1, 1), b3 + hstep, voffB); PG8_STAGE(PG8_SA(1, 0), a3, voffA);
            PG8_WAIT_V(8); PG8_WAIT_L(0); PG8_BAR; PG8_MMA(1, 0, At, B0); PG8_MMA(1, 1, At, B1); PG8_BAR; PG8_SCHED;
            } else {
            PG8_LDB(B0, 0, 0); PG8_SCHED; PG8_LDA(At, 0, 0); PG8_STAGE(PG8_SA(1, 1), a1 + hstep, voffA);
            PG8_WAIT_L(8); PG8_BAR; PG8_WAIT_L(0); PG8_MMA(0, 0, At, B0); PG8_BAR; PG8_SCHED;
            PG8_LDB(B1, 0, 1); PG8_STAGE(PG8_SB(0, 0), b2, voffB);
            PG8_BAR; PG8_WAIT_L(0); PG8_MMA(0, 1, At, B1); PG8_BAR;
            PG8_LDA(At, 0, 1); PG8_STAGE(PG8_SA(0, 0), a2, voffA);
            PG8_BAR; PG8_WAIT_L(0); PG8_MMA(1, 0, At, B0); PG8_BAR; PG8_SCHED;
            PG8_STAGE(PG8_SB(0, 1), b2 + hstep, voffB);
            PG8_WAIT_V(6); PG8_BAR; PG8_MMA(1, 1, At, B1); PG8_BAR;
            PG8_LDB(B0, 1, 0); PG8_SCHED; PG8_LDA(At, 1, 0); PG8_STAGE(PG8_SA(0, 1), a2 + hstep, voffA);
            PG8_WAIT_L(8); PG8_BAR; PG8_WAIT_L(0); PG8_MMA(0, 0, At, B0); PG8_BAR; PG8_SCHED;
            PG8_LDB(B1, 1, 1); PG8_STAGE(PG8_SB(1, 0), b3, voffB);
            PG8_BAR; PG8_WAIT_L(0); PG8_MMA(0, 1, At, B1); PG8_BAR;
            PG8_LDA(At, 1, 1); PG8_STAGE(PG8_SA(1, 0), a3, voffA);
            PG8_BAR; PG8_WAIT_L(0); PG8_MMA(1, 0, At, B0); PG8_BAR; PG8_SCHED;
            PG8_STAGE(PG8_SB(1, 1), b3 + hstep, voffB);
            PG8_WAIT_V(6); PG8_BAR; PG8_MMA(1, 1, At, B1); PG8_BAR;
            }
        }
        if constexpr (ALIGN_EPI) { if (wr == 0) PG8_BAR; }
        if constexpr (!Epi::AFTER_DRAIN) { E(acc, est, cur, wr, wc, fr, fq); S.done(cur); }
        if (!has_next) break;
        E.init(acc, est, nxt, wr, wc, fr, fq);
        cur = nxt; cA = nA; cB = nB; ++ui;
        if constexpr (ALIGN_EPI) { if (wr == 1) PG8_BAR; }
    }
    PG8_WAIT_V(0);
    if constexpr (!ALIGN_EPI) { if (wr == 0) PG8_BAR; }
    PG8_BAR;
    if constexpr (Epi::AFTER_DRAIN) { E.fused(acc, cur, wr, wc, fr, fq, lds, wid, lane); S.done(cur); }
#undef PG8_SA
#undef PG8_SB
#undef PG8_STAGE
#undef PG8_LDA
#undef PG8_LDB
#undef PG8_MMA
#undef PG8_WAIT_V
#undef PG8_WAIT_L
#undef PG8_BAR
#undef PG8_SCHED
}
}
#define LAS __attribute__((address_space(3)))
typedef unsigned short bf16;
typedef float f32x4 __attribute__((ext_vector_type(4)));
typedef float f32x2 __attribute__((ext_vector_type(2)));
typedef unsigned u32x4 __attribute__((ext_vector_type(4)));
typedef unsigned u32x2 __attribute__((ext_vector_type(2)));
typedef short bf16x8 __attribute__((ext_vector_type(8)));
typedef float f32x16 __attribute__((ext_vector_type(16)));
#define GAS __attribute__((address_space(1)))
__device__ __forceinline__ unsigned pk_bf16(float lo, float hi) { return pg8::cvt_pk_bf16(lo, hi); }
__device__ __forceinline__ float bf2f(unsigned short b) { return __uint_as_float(((unsigned)b) << 16); }
__device__ __forceinline__ float wave_sum(float v, int lane) {
#pragma unroll
    for (int o = 1; o < 64; o <<= 1) v += shx(v, o, lane);
    return v;
}
__device__ __forceinline__ float wave_max(float v, int lane) {
#pragma unroll
    for (int o = 1; o < 64; o <<= 1) v = fmaxf(v, shx(v, o, lane));
    return v;
}
#define XB_TMO      128
#define XB_XCNT(j)  (256  + 64 * (j))
#define XB_XSUB(j)  (1280 + 64 * (j))
#define XB_XGEN(j)  (2304 + 64 * (j))
#define XB_TOP      3328
#define XB_TOPGEN   3392
#define XCD_BAR_WORDS 3456
#define XB_SPIN_CAP (1u << 18)

__device__ __forceinline__ unsigned xb_ld(unsigned* p)              { return __hip_atomic_load(p, __ATOMIC_RELAXED, __HIP_MEMORY_SCOPE_AGENT); }
__device__ __forceinline__ unsigned xb_add(unsigned* p, unsigned v) { return __hip_atomic_fetch_add(p, v, __ATOMIC_RELAXED, __HIP_MEMORY_SCOPE_AGENT); }
__device__ __forceinline__ unsigned xb_xcc_id() { return (unsigned)__builtin_amdgcn_s_getreg((3 << 11) | 20) & 0xFu; }
#define XB_SPIN(cond, bar) do { unsigned _sp = 0; while (cond) { __builtin_amdgcn_s_sleep(1); \
    if ((++_sp & 255u) == 0u) { if (xb_ld(&(bar)[XB_TMO])) break; if (_sp > XB_SPIN_CAP) { atomicAdd(&(bar)[XB_TMO], 1u); break; } } } } while (0)

struct XcdBarrier {
    unsigned* bar; unsigned x;
    volatile LAS unsigned* st;
};

__device__ __forceinline__ XcdBarrier xcd_barrier_post(unsigned* bar, volatile LAS unsigned* st) {
    XcdBarrier b; b.bar = bar; b.x = xb_xcc_id(); b.st = st;
    if (threadIdx.x == 0) (void)xb_add(&bar[XB_XCNT(b.x)], 1u);
    return b;
}
__device__ __forceinline__ void xcd_barrier_complete(unsigned* bar, unsigned x, unsigned& nloc, unsigned& nx) {
    const unsigned G = gridDim.x * gridDim.y * gridDim.z;
    unsigned sum, cnt, mine, sp = 0u;
    for (;;) {
        sum = 0u; cnt = 0u; mine = 0u;
#pragma unroll
        for (unsigned j = 0; j < 16; ++j) { const unsigned c = xb_ld(&bar[XB_XCNT(j)]); sum += c; cnt += (c > 0u) ? 1u : 0u; mine = (j == x) ? c : mine; }
        if (sum == G) break;
        __builtin_amdgcn_s_sleep(1);
        if ((++sp & 255u) == 0u) { if (xb_ld(&bar[XB_TMO])) break; if (sp > XB_SPIN_CAP) { atomicAdd(&bar[XB_TMO], 1u); break; } }
    }
    nloc = mine > 0u ? mine : 1u; nx = cnt > 0u ? cnt : 1u;
}

__device__ __forceinline__ void xcd_barrier(const XcdBarrier& b) {
    asm volatile("s_waitcnt vmcnt(0)" ::: "memory");
    __syncthreads();
    if (threadIdx.x == 0) {
        unsigned* bar = b.bar;
        __builtin_amdgcn_s_waitcnt(0);
        unsigned nloc = b.st[0], nx = b.st[1];
        if (nloc == 0u) { xcd_barrier_complete(bar, b.x, nloc, nx); b.st[0] = nloc; b.st[1] = nx; }
        const unsigned old = xb_add(&bar[XB_XSUB(b.x)], 1u);
        const unsigned gen = old / nloc;
        if (old + 1u == (gen + 1u) * nloc) {
            __builtin_amdgcn_fence(__ATOMIC_RELEASE, "agent");
            asm volatile("s_waitcnt vmcnt(0)" ::: "memory");
            const unsigned og = xb_add(&bar[XB_TOP], 1u);
            const unsigned tg = og / nx;
            if (og + 1u == (tg + 1u) * nx) xb_add(&bar[XB_TOPGEN], 1u);
            else XB_SPIN(xb_ld(&bar[XB_TOPGEN]) == tg, bar);
            __builtin_amdgcn_fence(__ATOMIC_ACQUIRE, "agent");
            xb_add(&bar[XB_XGEN(b.x)], 1u);
            asm volatile("s_waitcnt vmcnt(0)" ::: "memory");
        } else {
            XB_SPIN(xb_ld(&bar[XB_XGEN(b.x)]) == gen, bar);
            __builtin_amdgcn_fence(__ATOMIC_ACQUIRE, "agent");
            asm volatile("s_waitcnt vmcnt(0)" ::: "memory");
        }
    }
    __syncthreads();
}

struct Params { const float* in[26]; float* out; unsigned char* ws; int lo, hi; };
struct Frame { LAS unsigned char* lds; int tid, lane, wave, G, gw, NGW; };
#define CAS __attribute__((address_space(4)))
struct Args { const unsigned char CAS* k;
    __device__ __forceinline__ const float* in(int i) const { return *(const float* const CAS*)(k + 8 * i); }
    __device__ __forceinline__ float* out() const { return *(float* const CAS*)(k + 8 * 26); }
    __device__ __forceinline__ unsigned char* ws() const { return *(unsigned char* const CAS*)(k + 8 * 27); } };
__device__ __forceinline__ Args get_args() { Args a; a.k = (const unsigned char CAS*)__builtin_amdgcn_kernarg_segment_ptr(); asm volatile("" : "+s"(a.k)); return a; }
__device__ __forceinline__ Frame make_frame(LAS unsigned char* lds) { Frame F; int tid = threadIdx.x; asm volatile("" : "+v"(tid)); F.lds = lds; F.tid = tid; F.lane = tid & 63; F.wave = __builtin_amdgcn_readfirstlane(tid >> 6); F.G = gridDim.x;
    F.gw = blockIdx.x * NWAVES + F.wave; F.NGW = F.G * NWAVES; return F; }
#define LDS_WAIT() asm volatile("s_waitcnt lgkmcnt(0)" ::: "memory")
enum { I_XP = 0, I_XS, I_ST, I_CK, I_CV, I_HNORM, I_HWQ, I_HWF, I_HWI, I_HWG, I_LBL, I_ONORM, I_HWO, I_KVNORM, I_WK, I_WV, I_KNORM, I_ANORM, I_AWQ, I_QNORM, I_SINKS, I_AWO, I_FNORM, I_WG, I_WU, I_WDN };

struct CDesc { const float* W; const float* g; bf16* dst; int K, N, mode, row_off, k0, n0; };
__device__ __forceinline__ void conv_load(const CDesc& d, f32x4 (&v)[16], float& gv, int lane) {
    const int c4 = lane & 15, r4 = lane >> 4;
#pragma unroll
    for (int i = 0; i < 16; ++i) v[i] = __builtin_nontemporal_load((const GAS f32x4*)((const GAS float*)d.W + (size_t)(d.k0 + 4 * i + r4) * d.N + d.n0 + 4 * c4));
    gv = d.g ? ((const GAS float*)d.g)[d.k0 + lane] : 1.0f;
}
__device__ __forceinline__ void conv_finish(const CDesc& d, f32x4 (&v)[16], float gv, LAS float* scr, int lane) {
    const int c4 = lane & 15, r4 = lane >> 4;
#pragma unroll
    for (int i = 0; i < 16; ++i) { const float gs = __int_as_float(__builtin_amdgcn_ds_bpermute((4 * i + r4) << 2, __float_as_int(gv)));
#pragma unroll
        for (int e = 0; e < 4; ++e) scr[(4 * c4 + e) * 65 + 4 * i + r4] = v[i][e] * gs; }
    LDS_WAIT();
    const int c = lane & 7;
    const int drow0 = (d.mode == 0) ? (d.row_off + d.n0) : ((d.n0 >> 7) * 256 + (d.n0 & 127) + (d.mode == 2 ? 128 : 0));
#pragma unroll
    for (int jn = 0; jn < 8; ++jn) { const int n = jn * 8 + (lane >> 3); const LAS float* s = scr + n * 65 + 8 * c;
        u32x4 o; o.x = pg8::cvt_pk_bf16(s[0], s[1]); o.y = pg8::cvt_pk_bf16(s[2], s[3]); o.z = pg8::cvt_pk_bf16(s[4], s[5]); o.w = pg8::cvt_pk_bf16(s[6], s[7]);
        __builtin_nontemporal_store(o, (GAS u32x4*)((GAS bf16*)d.dst + (size_t)(drow0 + n) * d.K + d.k0 + 8 * c)); }
    LDS_WAIT();
}
__host__ __device__ constexpr int conv_items(int L) { return L < 2 ? 5 * 1024 + 3 * 2816 : (L == 2 ? 2 * 256 + 2 * 1024 + 3 * 2816 : 2 * 1024 + 3 * 2816); }
__device__ __forceinline__ CDesc conv_desc(const Args& p, unsigned char* ws, int L, int idx) {
    constexpr int SQ = 2048 * 2048;
    const float* W; const float* g = nullptr; bf16* dst; int K = 2048, N = 2048, mode = 0, row_off = 0, loc; const int nproj = conv_items(L) - 3 * 2816;
    if (idx >= nproj) { const int r = idx - nproj, kind = r / 2816; loc = r - kind * 2816;
        if (kind == 0) { W = p.in(I_WG) + (size_t)L * DM * DFF; g = p.in(I_FNORM) + L * DM; dst = (bf16*)(ws + WS_WGU) + (size_t)L * 2 * DFF * DM; N = DFF; mode = 1; }
        else if (kind == 1) { W = p.in(I_WU) + (size_t)L * DM * DFF; g = p.in(I_FNORM) + L * DM; dst = (bf16*)(ws + WS_WGU) + (size_t)L * 2 * DFF * DM; N = DFF; mode = 2; }
        else { W = p.in(I_WDN) + (size_t)L * DM * DFF; dst = (bf16*)(ws + WS_WD) + (size_t)L * DM * DFF; K = DFF; N = DM; } }
    else if (L < 2) { const int jid = idx >> 10; loc = idx & 1023;
        if (jid < 4) { W = p.in(I_HWQ + jid) + (size_t)L * SQ; g = p.in(I_HNORM) + L * DM; dst = (bf16*)(ws + WS_WH) + (size_t)L * 8192 * 2048; row_off = jid * 2048; }
        else { W = p.in(I_HWO) + (size_t)L * SQ; dst = (bf16*)(ws + WS_WOH) + (size_t)L * SQ; } }
    else if (L == 2) {
        if (idx < 512) { const int w = idx >> 8; loc = idx & 255; N = 512; W = p.in(w ? I_WV : I_WK); g = p.in(I_KVNORM); dst = (bf16*)(ws + WS_WQKV0); row_off = w * 512; }
        else if (idx < 512 + 1024) { loc = idx - 512; W = p.in(I_AWQ); g = p.in(I_ANORM); dst = (bf16*)(ws + WS_WQKV0); row_off = 1024; }
        else { loc = idx - 1536; W = p.in(I_AWO); dst = (bf16*)(ws + WS_WOA); } }
    else { if (idx < 1024) { loc = idx; W = p.in(I_AWQ) + SQ; g = p.in(I_ANORM) + DM; dst = (bf16*)(ws + WS_WQ1); }
        else { loc = idx - 1024; W = p.in(I_AWO) + SQ; dst = (bf16*)(ws + WS_WOA) + SQ; } }
    const int nblk = N / 64, kb = loc / nblk, nb = loc - kb * nblk;
    return CDesc{W, g, dst, K, N, mode, row_off, 64 * kb, 64 * nb};
}
#ifndef CQ_H0
#define CQ_H0 8700
#define CQ_F0 12000
#define CQ_H1 7100
#define CQ_F1 10400
#define CQ_Q0 4400
#define CQ_F2 7680
#endif
__device__ __forceinline__ void conv_drain(LAS unsigned char* lds, int La, int qa, int Lb, int qb) {
    const Args p = get_args(); Frame F = make_frame(lds); unsigned char* ws = p.ws(); LAS float* scr = (LAS float*)(F.lds + F.wave * 16640);
    for (int r = 0; r < 2; ++r) { const int L = r ? Lb : La, quota = r ? qb : qa; if (quota <= 0) continue;
        unsigned* qc = (unsigned*)(ws + WS_CTL) + CW_Q + 64 * L; const int n = conv_items(L), lim = quota < n ? quota : n;
        for (;;) { int base = n;
            if (F.lane == 0) { if ((int)__hip_atomic_load(qc, __ATOMIC_RELAXED, __HIP_MEMORY_SCOPE_AGENT) < lim) base = (int)__hip_atomic_fetch_add(qc, 4u, __ATOMIC_RELAXED, __HIP_MEMORY_SCOPE_AGENT); }
            base = __builtin_amdgcn_readfirstlane(base);
            if (base >= n) break;
            f32x4 va[16], vb[16]; float ga, gb;
            CDesc da = conv_desc(p, ws, L, base), db = conv_desc(p, ws, L, base + 1); conv_load(da, va, ga, F.lane); conv_load(db, vb, gb, F.lane);
            conv_finish(da, va, ga, scr, F.lane); da = conv_desc(p, ws, L, base + 2); conv_load(da, va, ga, F.lane);
            conv_finish(db, vb, gb, scr, F.lane); db = conv_desc(p, ws, L, base + 3); conv_load(db, vb, gb, F.lane);
            conv_finish(da, va, ga, scr, F.lane); conv_finish(db, vb, gb, scr, F.lane); } }
}
__device__ __forceinline__ void phase_prologue(LAS unsigned char* lds) {
    const Args p = get_args(); Frame F = make_frame(lds); unsigned char* ws = p.ws(); LAS float* scr = (LAS float*)(F.lds + F.wave * 16640);
    { constexpr int n = conv_items(0); int it = F.gw;
      if (it < n) { f32x4 va[16], vb[16]; float ga, gb; CDesc da = conv_desc(p, ws, 0, it), db = da; conv_load(da, va, ga, F.lane);
        for (;;) { const int i1 = it + F.NGW; if (i1 < n) { db = conv_desc(p, ws, 0, i1); conv_load(db, vb, gb, F.lane); }
            conv_finish(da, va, ga, scr, F.lane); if (i1 >= n) break;
            const int i2 = i1 + F.NGW; if (i2 < n) { da = conv_desc(p, ws, 0, i2); conv_load(da, va, ga, F.lane); }
            conv_finish(db, vb, gb, scr, F.lane); if (i2 >= n) break; it = i2; } } }
    const int gt = F.gw * 64 + F.lane, NGT = F.NGW * 64;
    { GAS bf16* XB = (GAS bf16*)(ws + WS_XB); GAS float* RSB = (GAS float*)(ws + WS_RS) + MROWS;
      for (int r = F.gw; r < MROWS; r += F.NGW) { const float* src = (r < MP) ? p.in(I_XP) + (size_t)r * DM : p.in(I_XS) + (size_t)(r - MP) * DM;
          const GAS f32x4* xr = (const GAS f32x4*)src + F.lane; f32x4 v[8]; float s = 0.f;
#pragma unroll
          for (int j = 0; j < 8; ++j) { v[j] = xr[64 * j]; s += (v[j].x * v[j].x + v[j].y * v[j].y) + (v[j].z * v[j].z + v[j].w * v[j].w); }
          s = wave_sum(s, F.lane); if (F.lane == 0) RSB[r] = s;
          GAS u32x2* o8 = (GAS u32x2*)(XB + (size_t)r * DM) + F.lane;
#pragma unroll
          for (int j = 0; j < 8; ++j) o8[64 * j] = (u32x2){pg8::cvt_pk_bf16(v[j].x, v[j].y), pg8::cvt_pk_bf16(v[j].z, v[j].w)}; } }
    { float* LB = (float*)(ws + WS_LB); const float* lg = p.in(I_LBL);
      for (int c = gt; c < DM; c += NGT) { const float l0 = lg[c], l1 = lg[DM + c], m = fmaxf(l0, l1), e0 = expf(l0 - m), e1 = expf(l1 - m); LB[c] = 0.f; LB[DM + c] = e1 / (e0 + e1); } }
    { f32x2* TAB = (f32x2*)(ws + WS_ROPE);
      for (int idx = gt; idx < NPOS * 32; idx += NGT) { const int pi = idx >> 5, i = idx & 31; const double pos = (double)(pi < TP ? pi : 16384 + (pi - TP));
          double inv = 1.0; for (int k = 0; k < i; ++k) inv *= 0.7498942093324559;
          const double x = pos * inv, n = rint(x * 0.15915494309189535); double r = fma(-n, 6.283185307179586, x); r = fma(-n, 2.4492935982947064e-16, r);
          const double r2 = r * r; double s = 1.0, c = 1.0;
#pragma unroll
          for (int k = 14; k >= 1; --k) { s = 1.0 - r2 * (1.0 / (double)((2 * k) * (2 * k + 1))) * s; c = 1.0 - r2 * (1.0 / (double)((2 * k - 1) * (2 * k))) * c; }
          TAB[idx] = (f32x2){(float)c, (float)(r * s)}; } }
}

__device__ __forceinline__ f32x4 sample_row_reduce(const float* Xs, float* X, const float* SL, int rs, int ks_prev, int tid) {
    GAS f32x4* xp = (GAS f32x4*)(X + (size_t)(MP + rs) * DM) + tid; f32x4 v = *((const GAS f32x4*)(Xs + (size_t)rs * DM) + tid);
    if (ks_prev > 0) { const GAS f32x4* sp = (const GAS f32x4*)(SL + (size_t)rs * DM) + tid; f32x4 a0 = (f32x4){0.f, 0.f, 0.f, 0.f}, a1 = a0;
#pragma unroll 4
        for (int ks = 0; ks < ks_prev; ks += 2) { a0 += sp[(size_t)ks * 256 * (DM / 4)]; a1 += sp[(size_t)(ks + 1) * 256 * (DM / 4)]; }
        v += a0 + a1; *xp = v; }
    return v;
}
__device__ __forceinline__ void sample_reduce_publish(LAS unsigned char* lds, int ks_prev, const float* Xs, float* RSmine, float* RSzero, unsigned* cnt, int first_wg) {
    const Args p = get_args(); Frame F = make_frame(lds); float* X = p.out() + O_Y; const float* SL = (const float*)(p.ws() + WS_SLAB); GAS bf16* XB = (GAS bf16*)(p.ws() + WS_XB);
    for (int i = blockIdx.x * NTHREADS + F.tid; i < MP; i += F.G * NTHREADS) ((GAS float*)RSzero)[i] = 0.f;
    LAS float* red = (LAS float*)F.lds;
    for (int rs = (int)blockIdx.x - first_wg; rs >= 0 && rs < MS; rs += F.G - first_wg) {
        const int tid = F.tid; f32x4 v = *((const GAS f32x4*)(Xs + (size_t)rs * DM) + tid);
        { const GAS f32x4* sp = (const GAS f32x4*)(SL + (size_t)rs * DM) + tid; f32x4 t[22];
#pragma unroll
          for (int ks = 0; ks < 22; ++ks) t[ks] = (ks < ks_prev) ? sp[(size_t)ks * 256 * (DM / 4)] : (f32x4){0.f, 0.f, 0.f, 0.f};
#pragma unroll
          for (int ks = 0; ks < 22; ++ks) v += t[ks]; }
        GAS unsigned long long* xo = (GAS unsigned long long*)(X + (size_t)(MP + rs) * DM) + 2 * tid;
        __hip_atomic_store(xo, ((unsigned long long)__float_as_uint(v.y) << 32) | __float_as_uint(v.x), __ATOMIC_RELAXED, __HIP_MEMORY_SCOPE_AGENT);
        __hip_atomic_store(xo + 1, ((unsigned long long)__float_as_uint(v.w) << 32) | __float_as_uint(v.z), __ATOMIC_RELAXED, __HIP_MEMORY_SCOPE_AGENT);
        __hip_atomic_store((GAS unsigned long long*)(XB + (size_t)(MP + rs) * DM) + tid, ((unsigned long long)pg8::cvt_pk_bf16(v.z, v.w) << 32) | pg8::cvt_pk_bf16(v.x, v.y), __ATOMIC_RELAXED, __HIP_MEMORY_SCOPE_AGENT);
        const float s = wave_sum((v.x * v.x + v.y * v.y) + (v.z * v.z + v.w * v.w), F.lane);
        __syncthreads(); if (F.lane == 0) red[F.wave] = s; __syncthreads();
        if (tid == 0) { float tot = 0.f;
#pragma unroll
            for (int w = 0; w < NWAVES; ++w) tot += red[w];
            __hip_atomic_store((GAS unsigned*)(RSmine + MP + rs), __float_as_uint(tot), __ATOMIC_RELAXED, __HIP_MEMORY_SCOPE_AGENT); }
        asm volatile("s_waitcnt vmcnt(0)" ::: "memory"); __syncthreads();
        if (tid == 0) __hip_atomic_fetch_add(cnt, 1u, __ATOMIC_RELAXED, __HIP_MEMORY_SCOPE_AGENT);
    }
    __syncthreads();
}
__device__ __forceinline__ void phase_fix_sample(LAS unsigned char* lds, int ks_prev) {
    const Args p = get_args(); Frame F = make_frame(lds); float* X = p.out() + O_Y; const float* SL = (const float*)(p.ws() + WS_SLAB);
    for (int rs = blockIdx.x; rs < MS; rs += F.G) (void)sample_row_reduce(X + (size_t)MP * DM, X, SL, rs, ks_prev, F.tid);
}

struct GsIn { float S[32]; float st[8]; };
__device__ __forceinline__ void gs_issue(GsIn& x, const Args& p, unsigned char* ws, int l, int s, int tid) {
    const bf16* Q = (const bf16*)(ws + WS_Q); const bf16* V = (const bf16*)(ws + WS_V); const bf16* GT = (const bf16*)(ws + WS_GT); const float* LF = (const float*)(ws + WS_LF);
    const int b = s >> 4, h = s & 15, lane = tid & 63, dg = tid >> 6; const float* sin_ = p.in(I_ST) + ((size_t)(l * NBS + b) * NH + h) * DK * DK;
#pragma unroll
    for (int i = 0; i < 16; ++i) { const f32x2 v2 = *(const GAS f32x2*)(sin_ + (size_t)(dg * 16 + i) * DK + 2 * lane); x.S[2 * i] = v2.x; x.S[2 * i + 1] = v2.y; }
#pragma unroll
    for (int k = 0; k < 2; ++k) { const int e = tid + k * NTHREADS, t = e >> 7, c = e & 127; const size_t gi = (size_t)(MP + b * TS + t) * DM + h * DK + c;
        x.st[4 * k] = ((const GAS float*)LF)[gi]; x.st[4 * k + 1] = bf2f(((const GAS bf16*)Q)[gi]); x.st[4 * k + 2] = bf2f(((const GAS bf16*)V)[gi]); x.st[4 * k + 3] = bf2f(((const GAS bf16*)GT)[gi]); }
}
__device__ __forceinline__ void phase_gla_sample(LAS unsigned char* lds, int l) {
    static_assert(TS == 8 && NWAVES == 8 && DK == 128, "sample GLA mapping");
    const Args p = get_args(); Frame F = make_frame(lds); unsigned char* ws = p.ws(); float* const pout = p.out();
    LAS float* sf = (LAS float*)F.lds; LAS float* sk = sf + 1024; LAS float* sq = sf + 2048; LAS float* sv = sf + 3072; LAS float* sg = sf + 4096; LAS float* red = sf + 5120;
    bf16* H = (bf16*)(ws + WS_H); const float* gon = p.in(I_ONORM) + l * DK;
    const int tid = F.tid, lane = F.lane, dg = F.wave;
    int s = blockIdx.x; if (s >= NBS * NH) return;
    GsIn cur, nxt; gs_issue(cur, p, ws, l, s, tid);
    for (;;) {
        const int b = s >> 4, h = s & 15, sn = s + F.G; const bool more = sn < NBS * NH;
        __syncthreads();
#pragma unroll
        for (int k = 0; k < 2; ++k) { const int e = tid + k * NTHREADS; const float f = expf(cur.st[4 * k]); sf[e] = f; sk[e] = 1.0f - f; sq[e] = cur.st[4 * k + 1]; sv[e] = cur.st[4 * k + 2]; sg[e] = cur.st[4 * k + 3]; }
        if (more) gs_issue(nxt, p, ws, l, sn, tid);
        LDS_WAIT();
        __syncthreads();
#pragma unroll 2
        for (int t = 0; t < TS; ++t) { const f32x2 vt = *(const LAS f32x2*)(sv + t * 128 + 2 * lane); float op0 = 0.f, op1 = 0.f;
#pragma unroll
            for (int i4 = 0; i4 < 4; ++i4) { const f32x4 f4 = *(const LAS f32x4*)(sf + t * 128 + dg * 16 + i4 * 4), k4 = *(const LAS f32x4*)(sk + t * 128 + dg * 16 + i4 * 4), q4 = *(const LAS f32x4*)(sq + t * 128 + dg * 16 + i4 * 4);
#pragma unroll
                for (int e = 0; e < 4; ++e) { const int i = i4 * 4 + e; cur.S[2 * i] = f4[e] * cur.S[2 * i] + k4[e] * vt.x; cur.S[2 * i + 1] = f4[e] * cur.S[2 * i + 1] + k4[e] * vt.y; op0 += cur.S[2 * i] * q4[e]; op1 += cur.S[2 * i + 1] * q4[e]; } }
            *(LAS f32x2*)(red + (t * 8 + dg) * 128 + 2 * lane) = (f32x2){op0, op1}; }
        float* sout = pout + O_STS + ((size_t)(l * NBS + b) * NH + h) * DK * DK;
#pragma unroll
        for (int i = 0; i < 16; ++i) *(GAS f32x2*)(sout + (size_t)(dg * 16 + i) * DK + 2 * lane) = (f32x2){cur.S[2 * i], cur.S[2 * i + 1]};
        LDS_WAIT();
        __syncthreads();
        { const int t = F.wave, c0 = lane, c1 = lane + 64; float o0 = 0.f, o1 = 0.f;
#pragma unroll
            for (int d = 0; d < 8; ++d) { o0 += red[(t * 8 + d) * 128 + c0]; o1 += red[(t * 8 + d) * 128 + c1]; }
            const float rstd = 1.0f / sqrtf(wave_sum(o0 * o0 + o1 * o1, lane) * (1.0f / DK) + RMS_EPS);
            const float y0 = o0 * rstd * gon[c0] * sg[t * 128 + c0], y1 = o1 * rstd * gon[c1] * sg[t * 128 + c1];
            bf16* hp = H + (size_t)(MP + b * TS + t) * DM + h * DK;
            hp[c0] = (bf16)(pg8::cvt_pk_bf16(y0, 0.f) & 0xffffu); hp[c1] = (bf16)(pg8::cvt_pk_bf16(y1, 0.f) & 0xffffu); }
        if (!more) break;
        s = sn;
#pragma unroll
        for (int i = 0; i < 32; ++i) cur.S[i] = nxt.S[i];
#pragma unroll
        for (int i = 0; i < 8; ++i) cur.st[i] = nxt.st[i];
    }
}

__device__ __forceinline__ void phase_post(LAS unsigned char* lds, int j) {
    const Args p = get_args(); Frame F = make_frame(lds); unsigned char* ws = p.ws(); float* const pout = p.out(); const bf16* RAW = (const bf16*)(ws + WS_RAW); float* QF = (float*)(ws + WS_QF); float* KF = (float*)(ws + WS_KF); float* VF = (float*)(ws + WS_VF); const float* SLB = (const float*)(ws + WS_SLAB);
    GAS unsigned char* QC = (GAS unsigned char*)(ws + WS_QC); GAS unsigned char* KC = (GAS unsigned char*)(ws + WS_KC); GAS unsigned char* VC = (GAS unsigned char*)(ws + WS_VC);
    const int ld = (j == 0) ? 3072 : 2048, qoff = (j == 0) ? 1024 : 0; const float qn = p.in(I_QNORM)[j * HD + F.lane], kn = p.in(I_KNORM)[F.lane];
    const f32x2* TAB = (const f32x2*)(ws + WS_ROPE); const int lane = F.lane;
    { const int rr = lane >> 3, db = lane & 7; const int NHV = (j == 0) ? NQH + NKV : NQH;
      f32x4 qn4[2], kn4[2];
#pragma unroll
      for (int e = 0; e < 2; ++e) { qn4[e] = *(const f32x4*)(p.in(I_QNORM) + j * HD + 8 * db + 4 * e); kn4[e] = *(const f32x4*)(p.in(I_KNORM) + 8 * db + 4 * e); }
      for (int it4 = F.gw; it4 < (MP / 8) * NHV / 4; it4 += F.NGW) {
        const int item0 = it4 * 4, rg = item0 / NHV, hv0 = item0 - rg * NHV; const bool isK = hv0 >= NQH; const int hh0 = isK ? hv0 - NQH : hv0; const int r = rg * 8 + rr, t = r & (TP - 1), b = r >> 12;
        const bf16* src = RAW + (size_t)r * ld + (isK ? 0 : qoff) + hh0 * HD + 8 * db; f32x4 x0[4], x1[4]; u32x4 xr[4];
#pragma unroll
        for (int u = 0; u < 4; ++u) xr[u] = *(const GAS u32x4*)(src + u * HD);
#pragma unroll
        for (int u = 0; u < 4; ++u) { x0[u] = (f32x4){__uint_as_float(xr[u].x << 16), __uint_as_float(xr[u].x & 0xffff0000u), __uint_as_float(xr[u].y << 16), __uint_as_float(xr[u].y & 0xffff0000u)};
            x1[u] = (f32x4){__uint_as_float(xr[u].z << 16), __uint_as_float(xr[u].z & 0xffff0000u), __uint_as_float(xr[u].w << 16), __uint_as_float(xr[u].w & 0xffff0000u)}; }
        const f32x4* tb = (const f32x4*)(TAB + t * 32 + 8 * (db & 3)); f32x4 c2[4];
#pragma unroll
        for (int e2 = 0; e2 < 4; ++e2) c2[e2] = tb[e2];
        const f32x4 g0 = isK ? kn4[0] : qn4[0], g1 = isK ? kn4[1] : qn4[1];
#pragma unroll
        for (int u = 0; u < 4; ++u) { const int hh = hh0 + u;
            float ss = (x0[u].x * x0[u].x + x0[u].y * x0[u].y) + (x0[u].z * x0[u].z + x0[u].w * x0[u].w) + (x1[u].x * x1[u].x + x1[u].y * x1[u].y) + (x1[u].z * x1[u].z + x1[u].w * x1[u].w);
            ss += shx(ss, 1, lane); ss += shx(ss, 2, lane); ss += shx(ss, 4, lane);
            const float rstd = 1.0f / sqrtf(ss * (1.0f / HD) + RMS_EPS);
            float y[8] = {x0[u].x * rstd * g0.x, x0[u].y * rstd * g0.y, x0[u].z * rstd * g0.z, x0[u].w * rstd * g0.w, x1[u].x * rstd * g1.x, x1[u].y * rstd * g1.y, x1[u].z * rstd * g1.z, x1[u].w * rstd * g1.w};
            float o[8];
#pragma unroll
            for (int e2 = 0; e2 < 4; ++e2) { const float p0 = shx(y[2 * e2], 4, lane), p1 = shx(y[2 * e2 + 1], 4, lane);
                o[2 * e2] = (db < 4) ? (y[2 * e2] * c2[e2].x - p0 * c2[e2].y) : (y[2 * e2] * c2[e2].x + p0 * c2[e2].y); o[2 * e2 + 1] = (db < 4) ? (y[2 * e2 + 1] * c2[e2].z - p1 * c2[e2].w) : (y[2 * e2 + 1] * c2[e2].z + p1 * c2[e2].w); }
            const u32x4 w = (u32x4){pk_bf16(o[0], o[1]), pk_bf16(o[2], o[3]), pk_bf16(o[4], o[5]), pk_bf16(o[6], o[7])};
            if (!isK) *(GAS u32x4*)(QC + ((size_t)(((r >> 5) * 32 + hh) * 4 + (db >> 1))) * 1024 + ((db & 1) * 32 + (r & 31)) * 16) = w;
            else { *(GAS u32x4*)(KC + ((size_t)((b * NKV + hh) * (TP / 32) + (t >> 5)) * 4 + (db >> 1)) * 1024 + ((db & 1) * 32 + (t & 31)) * 16) = w;
                if (t >= TP - WIN) { float* kwo = pout + O_KWP + ((size_t)b * WIN + (t - (TP - WIN))) * KVW + hh * HD + 8 * db; *(f32x4*)kwo = (f32x4){o[0], o[1], o[2], o[3]}; *(f32x4*)(kwo + 4) = (f32x4){o[4], o[5], o[6], o[7]}; } } }
      } }
    if (j == 0) {
      for (int rg = F.gw; rg < MP / 4; rg += F.NGW) {
        const int r0 = rg * 4, t0 = r0 & (TP - 1), b = r0 >> 12; float vv[NKV][4];
#pragma unroll
        for (int hh = 0; hh < NKV; ++hh)
#pragma unroll
            for (int e = 0; e < 4; ++e) vv[hh][e] = bf2f(((const GAS bf16*)RAW)[(size_t)(r0 + e) * ld + KVW + hh * HD + lane]);
        const int kk = t0 & 31, sp = kk >> 4, k16 = kk & 15, hV = (k16 & 7) >> 2, jV = 4 * (k16 >> 3), dt = lane >> 5;
#pragma unroll
        for (int hh = 0; hh < NKV; ++hh) {
            *(GAS u32x2*)(VC + ((size_t)((b * NKV + hh) * (TP / 32) + (t0 >> 5)) * 4 + dt * 2 + sp) * 1024 + (hV * 32 + (lane & 31)) * 16 + jV * 2) = (u32x2){pk_bf16(vv[hh][0], vv[hh][1]), pk_bf16(vv[hh][2], vv[hh][3])};
            if (t0 >= TP - WIN) {
#pragma unroll
                for (int e = 0; e < 4; ++e) pout[O_VWP + ((size_t)b * WIN + (t0 + e - (TP - WIN))) * KVW + hh * HD + lane] = vv[hh][e]; } }
      } }
    const int NV = (j == 0) ? 48 : 32;
    for (int item0 = F.gw; item0 < MS * NV; item0 += 2 * F.NGW) {
        float xs[2]; int rs_[2], hv_[2]; bool ok[2];
#pragma unroll
        for (int u = 0; u < 2; ++u) { const int item = item0 + u * F.NGW; ok[u] = item < MS * NV; const int it = ok[u] ? item : item0; rs_[u] = it / NV; hv_[u] = it - rs_[u] * NV;
            const int kind = (j == 0) ? (hv_[u] < 8 ? 1 : (hv_[u] < 16 ? 2 : 0)) : 0; const int hh = (j == 0) ? (kind == 1 ? hv_[u] : (kind == 2 ? hv_[u] - 8 : hv_[u] - 16)) : hv_[u];
            const float* sp = SLB + (size_t)rs_[u] * ld + (kind == 0 ? qoff : (kind == 2 ? KVW : 0)) + hh * HD + lane; float x = 0.f;
#pragma unroll
            for (int ks = 0; ks < 8; ++ks) x += sp[(size_t)ks * 256 * ld];
            xs[u] = x; }
#pragma unroll
        for (int u = 0; u < 2; ++u) if (ok[u]) { const int rs = rs_[u], hv = hv_[u], r = MP + rs, s_ = rs & (TS - 1), b = rs >> 3; const float x = xs[u];
            const int kind = (j == 0) ? (hv < 8 ? 1 : (hv < 16 ? 2 : 0)) : 0;
            const int hh = (j == 0) ? (kind == 1 ? hv : (kind == 2 ? hv - 8 : hv - 16)) : hv;
            const f32x2 cs = TAB[(TP + s_) * 32 + (lane & 31)];
            const float y = x * (1.0f / sqrtf(wave_sum(x * x, lane) * (1.0f / HD) + RMS_EPS)) * (kind == 0 ? qn : kn); const float pr = shx(y, 32, lane);
            const float o = (lane < 32) ? (y * cs.x - pr * cs.y) : (y * cs.x + pr * cs.y);
            if (kind == 0) QF[(size_t)r * DM + hh * HD + lane] = o;
            else if (kind == 1) { KF[(size_t)r * KVW + hh * HD + lane] = o; pout[O_KWS + ((size_t)b * WIN + (WIN - TS + s_)) * KVW + hh * HD + lane] = o; }
            else { VF[(size_t)r * KVW + hh * HD + lane] = x; pout[O_VWS + ((size_t)b * WIN + (WIN - TS + s_)) * KVW + hh * HD + lane] = x; } }
    }
    if (j == 0) {
        const int gt = F.gw * 64 + lane, NGT = F.NGW * 64; const float* ck = p.in(I_CK); const float* cv = p.in(I_CV); constexpr int PER = (WIN - TS) * KVW;
        for (int i = gt; i < NBS * PER; i += NGT) { const int b = i / PER, rem = i - b * PER; const size_t d = (size_t)b * WIN * KVW + rem, s = d + (size_t)TS * KVW; pout[O_KWS + d] = ck[s]; pout[O_VWS + d] = cv[s]; }
    }
}

__device__ __forceinline__ void phase_attn_simple(LAS unsigned char* lds, int j) {
    static_assert(TS == NWAVES && HD == 64 && WIN == 128, "sample attention mapping");
    const Args p = get_args(); Frame F = make_frame(lds); unsigned char* ws = p.ws(); const float* QF = (const float*)(ws + WS_QF); const float* KF = (const float*)(ws + WS_KF); const float* VF = (const float*)(ws + WS_VF); bf16* H = (bf16*)(ws + WS_H);
    LAS float* sq = (LAS float*)F.lds + F.wave * 768; LAS float* sp = sq + 256; LAS float* KS = (LAS float*)(F.lds + 24576); LAS float* VS = (LAS float*)(F.lds + 61440);
    constexpr int NROW = WIN + TS - 1, KST = 68;
    const float* sinks = p.in(I_SINKS) + j * NQH; const float* ck = p.in(I_CK); const float* cv = p.in(I_CV); const int lane = F.lane;
    for (int u = blockIdx.x; u < NBS * NKV; u += F.G) {
        const int b = u >> 3, kvh = u & 7, t = F.wave, r = MP + b * TS + t;
        __syncthreads();
        f32x4 kx[5], vx[5];
#pragma unroll
        for (int i = 0; i < 5; ++i) { const int idx = F.tid + i * NTHREADS, row = idx >> 4, pc = idx & 15, a = row + 1;
            if (row < NROW) { const size_t off = (a < WIN) ? ((size_t)(b * WIN + a) * NKV + kvh) * HD : (size_t)(MP + b * TS + (a - WIN)) * KVW + kvh * HD;
                kx[i] = *(const GAS f32x4*)(((a < WIN) ? ck : KF) + off + 4 * pc); vx[i] = *(const GAS f32x4*)(((a < WIN) ? cv : VF) + off + 4 * pc); } }
#pragma unroll
        for (int g = 0; g < 4; ++g) sq[g * 64 + lane] = QF[(size_t)r * DM + (kvh * 4 + g) * HD + lane];
#pragma unroll
        for (int i = 0; i < 5; ++i) { const int idx = F.tid + i * NTHREADS, row = idx >> 4, pc = idx & 15;
            if (row < NROW) { *(LAS f32x4*)(KS + row * KST + 4 * pc) = kx[i]; *(LAS f32x4*)(VS + row * HD + 4 * pc) = vx[i]; } }
        LDS_WAIT();
        __syncthreads();
        float sc[2][4];
#pragma unroll
        for (int s2 = 0; s2 < 2; ++s2)
#pragma unroll
            for (int g = 0; g < 4; ++g) sc[s2][g] = 0.f;
        const LAS float* k0p = KS + (t + lane) * KST; const LAS float* k1p = k0p + 64 * KST;
#pragma unroll 2
        for (int d4 = 0; d4 < 16; ++d4) { const f32x4 ka = *(const LAS f32x4*)(k0p + 4 * d4), kb = *(const LAS f32x4*)(k1p + 4 * d4);
#pragma unroll
            for (int g = 0; g < 4; ++g) { const f32x4 q4 = *(const LAS f32x4*)(sq + g * 64 + 4 * d4);
                sc[0][g] += (q4.x * ka.x + q4.y * ka.y) + (q4.z * ka.z + q4.w * ka.w); sc[1][g] += (q4.x * kb.x + q4.y * kb.y) + (q4.z * kb.z + q4.w * kb.w); } }
#pragma unroll
        for (int g = 0; g < 4; ++g) { const float sk_ = sinks[kvh * 4 + g]; const float s0 = sc[0][g] * 0.125f, s1 = sc[1][g] * 0.125f;
            const float m = fmaxf(wave_max(fmaxf(s0, s1), lane), sk_); const float p0 = expf(s0 - m), p1 = expf(s1 - m);
            const float inv = 1.0f / (wave_sum(p0 + p1, lane) + expf(sk_ - m)); sp[g * 128 + lane] = p0 * inv; sp[g * 128 + 64 + lane] = p1 * inv; }
        LDS_WAIT();
        float acc[4] = {0.f, 0.f, 0.f, 0.f}; const LAS float* vrow = VS + t * HD + lane;
#pragma unroll 2
        for (int s4 = 0; s4 < 32; ++s4) { const float v0 = vrow[(4 * s4) * HD], v1 = vrow[(4 * s4 + 1) * HD], v2 = vrow[(4 * s4 + 2) * HD], v3 = vrow[(4 * s4 + 3) * HD];
#pragma unroll
            for (int g = 0; g < 4; ++g) { const f32x4 p4 = *(const LAS f32x4*)(sp + g * 128 + 4 * s4); acc[g] += (p4.x * v0 + p4.y * v1) + (p4.z * v2 + p4.w * v3); } }
#pragma unroll
        for (int g = 0; g < 4; ++g) H[(size_t)r * DM + (kvh * 4 + g) * HD + lane] = (bf16)(pg8::cvt_pk_bf16(acc[g], 0.f) & 0xffffu);
        LDS_WAIT();
    }
}


constexpr int OPS_QT = 0, OPS_KT = 8192, OPS_VF = 16384, OPS_AI = 24576, OPS_DEC = 26624, OPS_ITEM = 27648;
constexpr int NSEG = 8, SEG_STEPS = 16, NSTEPS = TP / 32;

__device__ __forceinline__ void phase_gla_pre(LAS unsigned char* lds, int l) {
    (void)l; const Args p = get_args(); Frame F = make_frame(lds); unsigned char* ws = p.ws();
    const GAS bf16* Q = (const GAS bf16*)(ws + WS_Q); const GAS bf16* V = (const GAS bf16*)(ws + WS_V); const GAS float* LF = (const GAS float*)(ws + WS_LF);
    GAS unsigned char* OPS = (GAS unsigned char*)(ws + WS_OPS);
    const int lane = F.lane; LAS unsigned char* QP = F.lds + F.wave * 17408; LAS unsigned char* KP = QP + 8704;
    const int pq = lane >> 4, dl = 2 * (lane & 15), qq = (dl < 16) ? (dl >> 2) : ((dl - 16) >> 2), jq = (dl < 16) ? (dl & 3) : (4 + ((dl - 16) & 3));
    const int c0 = 2 * lane, ti = c0 >> 4, tm = c0 & 15;
    for (int k = 0; k < ((NBP * NH * NSEG - 1 - (int)blockIdx.x) / F.G + 1) * 2; ++k) {
        const int u = blockIdx.x + (k >> 1) * F.G, it = (u >> 3) * NSTEPS + (u & 7) * SEG_STEPS + 2 * F.wave + (k & 1);
        const int s = it & (NSTEPS - 1), bh = it >> 7, b = bh >> 4, h = bh & 15; const size_t row0 = (size_t)b * TP + 32 * s; const int col = h * DK + c0;
        GAS unsigned char* ops = OPS + (size_t)it * OPS_ITEM;
        float g0[32], g1[32];
#pragma unroll
        for (int t = 0; t < 32; ++t) { const f32x2 x = *(const GAS f32x2*)(LF + (row0 + t) * DM + col); g0[t] = x.x; g1[t] = x.y; }
#pragma unroll
        for (int t = 1; t < 32; ++t) { g0[t] += g0[t - 1]; g1[t] += g1[t - 1]; }
        const float gl0 = g0[31], gl1 = g1[31], gm0 = g0[15], gm1 = g1[15];
        *(GAS f32x2*)(ops + OPS_DEC + lane * 8) = (f32x2){__expf(gl0), __expf(gl1)};
        unsigned qnx[8], vnx[8];
#pragma unroll
        for (int jj = 0; jj < 8; ++jj) { const size_t gi = (row0 + jj) * DM + col; qnx[jj] = *(const GAS unsigned*)(Q + gi); vnx[jj] = *(const GAS unsigned*)(V + gi); }
#pragma unroll
        for (int g = 0; g < 4; ++g) {
            unsigned qv[8], vv[8];
#pragma unroll
            for (int jj = 0; jj < 8; ++jj) { qv[jj] = qnx[jj]; vv[jj] = vnx[jj]; }
            if (g < 3) {
#pragma unroll
                for (int jj = 0; jj < 8; ++jj) { const size_t gi = (row0 + 8 * (g + 1) + jj) * DM + col; qnx[jj] = *(const GAS unsigned*)(Q + gi); vnx[jj] = *(const GAS unsigned*)(V + gi); } }
            float kh0[8], kh1[8];
#pragma unroll
            for (int jj = 0; jj < 8; ++jj) { const int t = 8 * g + jj; const float q0 = __uint_as_float(qv[jj] << 16), q1 = __uint_as_float(qv[jj] & 0xffff0000u);
                const float k0 = 1.0f - __expf(t ? g0[t] - g0[t - 1] : g0[0]), k1 = 1.0f - __expf(t ? g1[t] - g1[t - 1] : g1[0]);
                *(GAS unsigned*)(ops + OPS_QT + ((((t >> 4) * 4 + pq) * 64 + (qq * 16 + (t & 15))) * 16) + jq * 2) = pk_bf16(q0 * __expf(g0[t]), q1 * __expf(g1[t]));
                *(LAS unsigned*)(QP + t * 272 + lane * 4) = pk_bf16(q0 * __expf(g0[t] - gm0), q1 * __expf(g1[t] - gm1));
                *(LAS unsigned*)(KP + t * 272 + lane * 4) = pk_bf16(k0 * __expf(gm0 - g0[t]), k1 * __expf(gm1 - g1[t]));
                kh0[jj] = k0 * __expf(gl0 - g0[t]); kh1[jj] = k1 * __expf(gl1 - g1[t]); }
            u32x4 w0, w1, x0, x1;
            w0.x = pk_bf16(kh0[0], kh0[1]); w0.y = pk_bf16(kh0[2], kh0[3]); w0.z = pk_bf16(kh0[4], kh0[5]); w0.w = pk_bf16(kh0[6], kh0[7]);
            w1.x = pk_bf16(kh1[0], kh1[1]); w1.y = pk_bf16(kh1[2], kh1[3]); w1.z = pk_bf16(kh1[4], kh1[5]); w1.w = pk_bf16(kh1[6], kh1[7]);
            x0.x = (vv[0] & 0xffffu) | (vv[1] << 16); x0.y = (vv[2] & 0xffffu) | (vv[3] << 16); x0.z = (vv[4] & 0xffffu) | (vv[5] << 16); x0.w = (vv[6] & 0xffffu) | (vv[7] << 16);
            x1.x = (vv[0] >> 16) | (vv[1] & 0xffff0000u); x1.y = (vv[2] >> 16) | (vv[3] & 0xffff0000u); x1.z = (vv[4] >> 16) | (vv[5] & 0xffff0000u); x1.w = (vv[6] >> 16) | (vv[7] & 0xffff0000u);
            const int off = ti * 1024 + (g * 16 + tm) * 16;
            *(GAS u32x4*)(ops + OPS_KT + off) = w0; *(GAS u32x4*)(ops + OPS_KT + off + 16) = w1;
            *(GAS u32x4*)(ops + OPS_VF + off) = x0; *(GAS u32x4*)(ops + OPS_VF + off + 16) = x1;
        }
        LDS_WAIT();
        f32x16 acc;
#pragma unroll
        for (int r = 0; r < 16; ++r) acc[r] = 0.f;
#pragma unroll
        for (int ks = 0; ks < 8; ++ks) { const int o = (lane & 31) * 272 + (16 * ks + 8 * (lane >> 5)) * 2;
            const bf16x8 a = *(const LAS bf16x8*)(QP + o), bb = *(const LAS bf16x8*)(KP + o); acc = __builtin_amdgcn_mfma_f32_32x32x16_bf16(a, bb, acc, 0, 0, 0); }
        { const int j = lane & 31;
#pragma unroll
          for (int r = 0; r < 16; ++r) { const int t = (r & 3) + 8 * (r >> 2) + 4 * (lane >> 5); const float val = (j <= t) ? acc[r] : 0.f;
              *(GAS bf16*)(ops + OPS_AI + (t >> 4) * 1024 + ((j >> 3) * 16 + (t & 15)) * 16 + (j & 7) * 2) = (bf16)(pk_bf16(val, 0.f) & 0xffffu); } }
        LDS_WAIT();
    }
}

template <bool OUT> __device__ __forceinline__ void gla_seq(LAS unsigned char* lds, int l) {
    const Args p = get_args(); Frame F = make_frame(lds); unsigned char* ws = p.ws();
    constexpr int NPW = OUT ? 5 : 3, NCH = OUT ? 35 : 17, SLOT = NPW * 8 * 1024;
    constexpr int L_QT = 0, L_KT = OUT ? 8192 : 0, L_VF = OUT ? 16384 : 8192, L_AI = 24576, L_DEC = OUT ? 26624 : 16384, L_GT = 27648;
    LAS unsigned char* ssb = F.lds + 3 * SLOT;
    const int lane0 = F.lane, w = F.wave;
    const GAS unsigned char* OPS = (const GAS unsigned char*)(ws + WS_OPS); const GAS bf16* GT = (const GAS bf16*)(ws + WS_GT);
    GAS float* SLOC = (GAS float*)(ws + WS_SLOC); GAS float* DSEG = (GAS float*)(ws + WS_DSEG); GAS bf16* H = (GAS bf16*)(ws + WS_H);
    for (int u = blockIdx.x; u < NBP * NH * NSEG; u += F.G) {
        const int seg = u & (NSEG - 1), bh = u >> 3, b = bh >> 4, h = bh & 15; const int item0 = bh * NSTEPS + seg * SEG_STEPS; const size_t row0 = (size_t)b * TP + seg * (SEG_STEPS * 32);
        f32x4 Sacc[8];
#pragma unroll
        for (int i = 0; i < 8; ++i) Sacc[i] = (f32x4){0.f, 0.f, 0.f, 0.f};
        f32x4 gon = (f32x4){0.f, 0.f, 0.f, 0.f}; f32x4 P[8];
        if constexpr (OUT) {
            gon = *(const GAS f32x4*)((const GAS float*)p.in(I_ONORM) + l * DK + 16 * w + 4 * (lane0 >> 4));
            if (seg > 0) { f32x4 da[8], sa[8], db[8], sb[8];
                auto ldseg = [&](int g, f32x4 (&d)[8], f32x4 (&sl)[8]) { const int ug = bh * NSEG + g;
#pragma unroll
                    for (int i = 0; i < 8; ++i) { d[i] = *(const GAS f32x4*)(DSEG + (size_t)ug * DK + 16 * i + 4 * (lane0 >> 4)); sl[i] = *(const GAS f32x4*)(SLOC + (((size_t)ug * 8 + w) * 8 + i) * 256 + lane0 * 4); } };
                for (int g = 0; g < seg; g += 2) { const bool two = g + 1 < seg;
                    ldseg(g, da, sa); ldseg(two ? g + 1 : g, db, sb);
#pragma unroll
                    for (int i = 0; i < 8; ++i) Sacc[i] = da[i] * Sacc[i] + sa[i];
                    if (two) {
#pragma unroll
                        for (int i = 0; i < 8; ++i) Sacc[i] = db[i] * Sacc[i] + sb[i]; } } }
        } else {
#pragma unroll
            for (int i = 0; i < 8; ++i) P[i] = (f32x4){1.f, 1.f, 1.f, 1.f};
        }
        int lane = lane0; asm volatile("" : "+v"(lane));
        const int n = lane & 15, q = lane >> 4;
        auto issue = [&](int s) { const int sc = s < SEG_STEPS ? s : SEG_STEPS - 1; const GAS unsigned char* ops = OPS + (size_t)(item0 + sc) * OPS_ITEM; LAS unsigned char* slot = F.lds + (s % 3) * SLOT;
#pragma unroll
            for (int k = 0; k < NPW; ++k) { int c = w + 8 * k; const int cl = c; if (c >= NCH) c = NCH - 1; const GAS unsigned char* src;
                if constexpr (OUT) { if (c < 27) src = ops + c * 1024 + lane * 16; else src = (const GAS unsigned char*)(GT + (row0 + 32 * sc + 4 * (c - 27) + (lane >> 4)) * DM + h * DK) + (lane & 15) * 16; }
                else { src = ops + (c < 16 ? OPS_KT + c * 1024 : OPS_DEC) + lane * 16; }
                __builtin_amdgcn_global_load_lds((const GAS unsigned*)src, (LAS unsigned*)(slot + cl * 1024), 16, 0, 0); } };
        issue(0); issue(1);
        f32x4 OT[2]; OT[0] = (f32x4){0.f, 0.f, 0.f, 0.f}; OT[1] = OT[0]; u32x2 gtr[2]; gtr[0] = (u32x2){0u, 0u}; gtr[1] = gtr[0];
        auto finalize = [&](int s) {
#pragma unroll
            for (int nt = 0; nt < 2; ++nt) { float tot = 0.f;
#pragma unroll
                for (int ww = 0; ww < 8; ++ww) tot += *(const LAS float*)(ssb + (((s & 1) * 8 + ww) * 32 + 16 * nt + n) * 4);
                const float rstd = 1.0f / sqrtf(tot * (1.0f / DK) + RMS_EPS);
                const float g0 = __uint_as_float(gtr[nt].x << 16), g1 = __uint_as_float(gtr[nt].x & 0xffff0000u), g2 = __uint_as_float(gtr[nt].y << 16), g3 = __uint_as_float(gtr[nt].y & 0xffff0000u);
                const u32x2 o = (u32x2){pk_bf16(OT[nt][0] * rstd * gon[0] * g0, OT[nt][1] * rstd * gon[1] * g1), pk_bf16(OT[nt][2] * rstd * gon[2] * g2, OT[nt][3] * rstd * gon[3] * g3)};
                *(GAS u32x2*)(H + (row0 + 32 * s + 16 * nt + n) * DM + h * DK + 16 * w + 4 * q) = o; } };
        for (int s = 0; s < SEG_STEPS; ++s) {
            if constexpr (OUT) asm volatile("s_waitcnt vmcnt(5)" ::: "memory"); else asm volatile("s_waitcnt vmcnt(3)" ::: "memory");
            __builtin_amdgcn_s_barrier(); asm volatile("" ::: "memory");
            if constexpr (OUT) { if (s >= 1) finalize(s - 1); }
            issue(s + 2);
            const LAS unsigned char* slot = F.lds + (s % 3) * SLOT;
            const bf16x8 vf = *(const LAS bf16x8*)(slot + L_VF + w * 1024 + lane * 16);
            if constexpr (OUT) {
                bf16x8 sf[4];
#pragma unroll
                for (int pp = 0; pp < 4; ++pp) { u32x4 t; t.x = pk_bf16(Sacc[2 * pp][0], Sacc[2 * pp][1]); t.y = pk_bf16(Sacc[2 * pp][2], Sacc[2 * pp][3]); t.z = pk_bf16(Sacc[2 * pp + 1][0], Sacc[2 * pp + 1][1]); t.w = pk_bf16(Sacc[2 * pp + 1][2], Sacc[2 * pp + 1][3]);
                    sf[pp] = __builtin_bit_cast(bf16x8, t); }
#pragma unroll
                for (int nt = 0; nt < 2; ++nt) { f32x4 o = (f32x4){0.f, 0.f, 0.f, 0.f};
#pragma unroll
                    for (int pp = 0; pp < 4; ++pp) { const bf16x8 qt = *(const LAS bf16x8*)(slot + L_QT + (nt * 4 + pp) * 1024 + lane * 16); o = __builtin_amdgcn_mfma_f32_16x16x32_bf16(sf[pp], qt, o, 0, 0, 0); }
                    const bf16x8 ai = *(const LAS bf16x8*)(slot + L_AI + nt * 1024 + lane * 16); o = __builtin_amdgcn_mfma_f32_16x16x32_bf16(vf, ai, o, 0, 0, 0);
                    OT[nt] = o; gtr[nt] = *(const LAS u32x2*)(slot + L_GT + (16 * nt + n) * 256 + (16 * w + 4 * q) * 2);
                    float ss = (o[0] * o[0] + o[1] * o[1]) + (o[2] * o[2] + o[3] * o[3]); ss += shx(ss, 16, lane); ss += shx(ss, 32, lane);
                    if (q == 0) *(LAS float*)(ssb + (((s & 1) * 8 + w) * 32 + 16 * nt + n) * 4) = ss; }
            }
#pragma unroll
            for (int i = 0; i < 8; ++i) { const f32x4 d = *(const LAS f32x4*)(slot + L_DEC + (16 * i + 4 * q) * 4); const bf16x8 kt = *(const LAS bf16x8*)(slot + L_KT + i * 1024 + lane * 16);
                if constexpr (!OUT) P[i] = P[i] * d;
                Sacc[i] = __builtin_amdgcn_mfma_f32_16x16x32_bf16(kt, vf, d * Sacc[i], 0, 0, 0); }
            LDS_WAIT();
        }
        asm volatile("s_waitcnt vmcnt(0)" ::: "memory");
        __builtin_amdgcn_s_barrier(); asm volatile("" ::: "memory");
        if constexpr (OUT) {
            finalize(SEG_STEPS - 1);
            if (seg == NSEG - 1) { GAS float* so = (GAS float*)p.out() + O_STP + ((size_t)(l * NBP + b) * NH + h) * DK * DK;
#pragma unroll
                for (int i = 0; i < 8; ++i)
#pragma unroll
                    for (int r = 0; r < 4; ++r) so[(size_t)(16 * i + 4 * q + r) * DK + 16 * w + n] = Sacc[i][r]; }
        } else {
#pragma unroll
            for (int i = 0; i < 8; ++i) { *(GAS f32x4*)(SLOC + (((size_t)u * 8 + w) * 8 + i) * 256 + lane * 4) = Sacc[i]; if (w == 0 && n == 0) *(GAS f32x4*)(DSEG + (size_t)u * DK + 16 * i + 4 * q) = P[i]; }
        }
        asm volatile("s_waitcnt vmcnt(0) lgkmcnt(0)" ::: "memory");
        __builtin_amdgcn_s_barrier(); asm volatile("" ::: "memory");

    }
}

__device__ __forceinline__ void phase_attn_prompt(LAS unsigned char* lds, int j) {
    const Args p = get_args(); Frame F = make_frame(lds); unsigned char* ws = p.ws();
    const GAS unsigned char* QC = (const GAS unsigned char*)(ws + WS_QC); const GAS unsigned char* KC = (const GAS unsigned char*)(ws + WS_KC); const GAS unsigned char* VC = (const GAS unsigned char*)(ws + WS_VC); GAS bf16* H = (GAS bf16*)(ws + WS_H);
    const int lane = F.lane, w = F.wave, g = w >> 1, rh = w & 1, ql = lane & 31, hl = lane >> 5;
    for (int u = blockIdx.x; u < NBP * NKV * (TP / 64); u += F.G) {
        const int qb = u & 63, kvh = (u >> 6) & 7, b = u >> 9, hq = kvh * 4 + g, qt = qb * 2 + rh;
        const float sink = p.in(I_SINKS)[j * NQH + hq];
        bf16x8 qf[4];
#pragma unroll
        for (int s = 0; s < 4; ++s) qf[s] = *(const GAS bf16x8*)(QC + ((size_t)((b * (TP / 32) + qt) * 32 + hq) * 4 + s) * 1024 + lane * 16);
        const GAS unsigned char* kbase = KC + (size_t)((b * NKV + kvh) * (TP / 32)) * 4096; const GAS unsigned char* vbase = VC + (size_t)((b * NKV + kvh) * (TP / 32)) * 4096;
        bf16x8 kf[3][4];
#pragma unroll
        for (int ti = 0; ti < 3; ++ti) { const int kt = qt - 4 + ti, ktc = kt < 0 ? 0 : kt;
#pragma unroll
            for (int s = 0; s < 4; ++s) kf[ti][s] = *(const GAS bf16x8*)(kbase + (size_t)(ktc * 4 + s) * 1024 + lane * 16); }
        f32x16 st[5];
#pragma unroll
        for (int ti = 0; ti < 5; ++ti) { const int kt = qt - 4 + ti; f32x16 acc;
#pragma unroll
            for (int r = 0; r < 16; ++r) acc[r] = 0.f;
#pragma unroll
            for (int s = 0; s < 4; ++s) acc = __builtin_amdgcn_mfma_f32_32x32x16_bf16(kf[ti % 3][s], qf[s], acc, 0, 0, 0);
            if (ti + 3 < 5) { const int k2 = qt - 1 + ti, k2c = k2 < 0 ? 0 : k2; asm volatile("" : "+v"(acc) :: "memory");
#pragma unroll
                for (int s = 0; s < 4; ++s) kf[ti % 3][s] = *(const GAS bf16x8*)(kbase + (size_t)(k2c * 4 + s) * 1024 + lane * 16); }
#pragma unroll
            for (int r = 0; r < 16; ++r) { const int krow = (r & 3) + 8 * (r >> 2) + 4 * hl; float x = acc[r] * 0.125f;
                if (ti == 0) x = (krow > ql) ? x : -1e30f;
                if (ti == 4) x = (krow <= ql) ? x : -1e30f;
                st[ti][r] = (kt >= 0) ? x : -1e30f; } }
        asm volatile("" : "+v"(st[4]) :: "memory");
        bf16x8 vfa[3][2][2];
#pragma unroll
        for (int ti = 0; ti < 3; ++ti) { const int kt = qt - 4 + ti, ktc = kt < 0 ? 0 : kt;
#pragma unroll
            for (int sp = 0; sp < 2; ++sp)
#pragma unroll
                for (int dt = 0; dt < 2; ++dt) vfa[ti][sp][dt] = *(const GAS bf16x8*)(vbase + (size_t)(ktc * 4 + dt * 2 + sp) * 1024 + lane * 16); }
        float mx = -1e30f;
#pragma unroll
        for (int ti = 0; ti < 5; ++ti)
#pragma unroll
            for (int r = 0; r < 16; ++r) mx = fmaxf(mx, st[ti][r]);
        mx = fmaxf(mx, shx(mx, 32, lane)); mx = fmaxf(mx, sink);
        float sum = 0.f;
#pragma unroll
        for (int ti = 0; ti < 5; ++ti)
#pragma unroll
            for (int r = 0; r < 16; ++r) { const float e = __expf(st[ti][r] - mx); st[ti][r] = e; sum += e; }
        sum += shx(sum, 32, lane);
        const float inv = 1.0f / (sum + __expf(sink - mx));
        f32x16 ot[2];
#pragma unroll
        for (int r = 0; r < 16; ++r) { ot[0][r] = 0.f; ot[1][r] = 0.f; }
#pragma unroll
        for (int ti = 0; ti < 5; ++ti) {
#pragma unroll
            for (int sp = 0; sp < 2; ++sp) { u32x4 t; t.x = pk_bf16(st[ti][8 * sp + 0], st[ti][8 * sp + 1]); t.y = pk_bf16(st[ti][8 * sp + 2], st[ti][8 * sp + 3]); t.z = pk_bf16(st[ti][8 * sp + 4], st[ti][8 * sp + 5]); t.w = pk_bf16(st[ti][8 * sp + 6], st[ti][8 * sp + 7]);
                const bf16x8 pf = __builtin_bit_cast(bf16x8, t);
#pragma unroll
                for (int dt = 0; dt < 2; ++dt) ot[dt] = __builtin_amdgcn_mfma_f32_32x32x16_bf16(vfa[ti % 3][sp][dt], pf, ot[dt], 0, 0, 0); }
            if (ti + 3 < 5) { const int k2 = qt - 1 + ti, k2c = k2 < 0 ? 0 : k2; asm volatile("" : "+v"(ot[0]), "+v"(ot[1]) :: "memory");
#pragma unroll
                for (int sp = 0; sp < 2; ++sp)
#pragma unroll
                    for (int dt = 0; dt < 2; ++dt) vfa[ti % 3][sp][dt] = *(const GAS bf16x8*)(vbase + (size_t)(k2c * 4 + dt * 2 + sp) * 1024 + lane * 16); } }
        GAS bf16* orow = H + ((size_t)b * TP + 32 * qt + ql) * DM + hq * HD + 4 * hl;
#pragma unroll
        for (int dt = 0; dt < 2; ++dt)
#pragma unroll
            for (int rq = 0; rq < 4; ++rq) *(GAS u32x2*)(orow + 32 * dt + 8 * rq) = (u32x2){pk_bf16(ot[dt][4 * rq] * inv, ot[dt][4 * rq + 1] * inv), pk_bf16(ot[dt][4 * rq + 2] * inv, ot[dt][4 * rq + 3] * inv)};
    }
}

constexpr int N_PHASES = 1 + 2 * 6 + 2 * 6 + 1;
#ifndef ONLY
#define ONLY 0
#endif
#ifndef MASK
#define MASK 0
#endif
#define SEL(k) ((ONLY == 0 && MASK == 0) || ONLY == (k) || ((MASK >> (k)) & 1))
__device__ __forceinline__ void gphase_hproj(LAS unsigned char* lds, int l) {
    const Args p = get_args(); unsigned char* ws = p.ws(); int tid = threadIdx.x; asm volatile("" : "+v"(tid));
    float* RSA = (float*)(ws + WS_RS); float* RSB = RSA + MROWS; unsigned* cnt = (unsigned*)(ws + WS_CTL) + CW_CNT + 64 * (2 * l);
    if (l > 0) sample_reduce_publish(lds, 22, p.out() + O_Y + (size_t)MP * DM, RSB, RSA, cnt, 32);
    else { for (int i = blockIdx.x * NTHREADS + tid; i < MP; i += (int)gridDim.x * NTHREADS) ((GAS float*)RSA)[i] = 0.f; }
    pg8::Gemm g{(const bf16*)(ws + WS_XB), (const bf16*)(ws + WS_WH) + (size_t)l * 8192 * 2048, MROWS, 8192, DM}; pg8::StaticOrder S; S.init(MROWS, 8192, DM, (int)gridDim.x, (int)blockIdx.x); S.cnt = cnt; S.need = (l > 0) ? (unsigned)MS : 0u; S.tmo = (unsigned*)(ws + WS_CTL) + CW_TMO2;
    pg8::EpiHproj E{ws, l};
    pg8::gemm_phase<pg8::EpiHproj, pg8::StaticOrder, true, true>(lds, g, S, E, tid);
}
__device__ __forceinline__ void gphase_qkv(LAS unsigned char* lds, int j) {
    const Args p = get_args(); unsigned char* ws = p.ws(); int tid = threadIdx.x; asm volatile("" : "+v"(tid));
    float* RSA = (float*)(ws + WS_RS); float* RSB = RSA + MROWS; unsigned* cnt = (unsigned*)(ws + WS_CTL) + CW_CNT + 64 * (2 * (j + 2));
    sample_reduce_publish(lds, 22, p.out() + O_Y + (size_t)MP * DM, RSB, RSA, cnt, j == 0 ? 128 : 64);
    const int N = (j == 0) ? 3072 : 2048; pg8::Gemm g{(const bf16*)(ws + WS_XB), (const bf16*)(ws + (j == 0 ? WS_WQKV0 : WS_WQ1)), MROWS, N, DM}; pg8::SplitOrder S; S.init(N, DM, 8, (int)gridDim.x, (int)blockIdx.x); S.cnt = cnt; S.need = (unsigned)MS; S.tmo = (unsigned*)(ws + WS_CTL) + CW_TMO2;
    pg8::EpiRaw E{(bf16*)(ws + WS_RAW), N, (float*)(ws + WS_SLAB), RSB};
    pg8::gemm_phase<pg8::EpiRaw, pg8::SplitOrder, true, true>(lds, g, S, E, tid);
}
__device__ __forceinline__ void gphase_wo(LAS unsigned char* lds, int l) {
    const Args p = get_args(); unsigned char* ws = p.ws(); int tid = threadIdx.x; asm volatile("" : "+v"(tid));
    const bf16* Bt = (l < 2) ? (const bf16*)(ws + WS_WOH) + (size_t)l * DM * DM : (const bf16*)(ws + WS_WOA) + (size_t)(l - 2) * DM * DM;
    pg8::Gemm g{(const bf16*)(ws + WS_H), Bt, MROWS, DM, DM}; pg8::SplitOrder S; S.init(DM, DM, 8, (int)gridDim.x, (int)blockIdx.x, 1); S.cnt = nullptr; S.need = 0u; S.tmo = nullptr; pg8::EpiResid E{(l == 0) ? p.in(I_XP) : nullptr, nullptr, DM, (float*)(ws + WS_SLAB), (bf16*)(ws + WS_XB), (bf16*)(ws + WS_XL), (float*)(ws + WS_RS)};
    pg8::gemm_phase<pg8::EpiResid, pg8::SplitOrder, true, true>(lds, g, S, E, tid);
}
__device__ __forceinline__ void gphase_ffn1(LAS unsigned char* lds, int l) {
    const Args p = get_args(); unsigned char* ws = p.ws(); int tid = threadIdx.x; asm volatile("" : "+v"(tid));
    float* RSA = (float*)(ws + WS_RS); float* RSB = RSA + MROWS; unsigned* cnt = (unsigned*)(ws + WS_CTL) + CW_CNT + 64 * (2 * l + 1);
    sample_reduce_publish(lds, 8, (l == 0) ? p.in(I_XS) : p.out() + O_Y + (size_t)MP * DM, RSA, RSB, cnt, 172);
    pg8::Gemm g{(const bf16*)(ws + WS_XB), (const bf16*)(ws + WS_WGU) + (size_t)l * 2 * DFF * DM, MROWS, 2 * DFF, DM}; pg8::StaticOrder S; S.init(MROWS, 2 * DFF, DM, (int)gridDim.x, (int)blockIdx.x); S.cnt = cnt; S.need = (unsigned)MS; S.tmo = (unsigned*)(ws + WS_CTL) + CW_TMO2; pg8::EpiFfn1 E{(bf16*)(ws + WS_ACT), DFF, RSA};
    pg8::gemm_phase<pg8::EpiFfn1, pg8::StaticOrder, true, true>(lds, g, S, E, tid);
}
__device__ __forceinline__ void gphase_ffn2(LAS unsigned char* lds, int l) {
    const Args p = get_args(); unsigned char* ws = p.ws(); int tid = threadIdx.x; asm volatile("" : "+v"(tid));
    pg8::Gemm g{(const bf16*)(ws + WS_ACT), (const bf16*)(ws + WS_WD) + (size_t)l * DM * DFF, MROWS, DM, DFF}; pg8::SplitOrder S; S.init(DM, DFF, 22, (int)gridDim.x, (int)blockIdx.x, 1); S.cnt = nullptr; S.need = 0u; S.tmo = nullptr; pg8::EpiResid E{nullptr, (l == 3) ? p.out() + O_Y : nullptr, DM, (float*)(ws + WS_SLAB), (bf16*)(ws + WS_XB), (bf16*)(ws + WS_XL), (float*)(ws + WS_RS) + MROWS};
    pg8::gemm_phase<pg8::EpiResid, pg8::SplitOrder, true, true>(lds, g, S, E, tid);
}
#ifndef V1_SPLIT
#define V1_SPLIT 0
#endif
#if V1_SPLIT
__global__ void __launch_bounds__(NTHREADS, 2) k_gla(Params prm, int l) { extern __shared__ __attribute__((aligned(16))) unsigned char lds_raw[]; (void)prm; phase_gla_sample((LAS unsigned char*)lds_raw, l); }
__global__ void __launch_bounds__(NTHREADS, 2) k_attn(Params prm, int j) { extern __shared__ __attribute__((aligned(16))) unsigned char lds_raw[]; (void)prm; phase_attn_simple((LAS unsigned char*)lds_raw, j); }
#endif
__global__ void __launch_bounds__(NTHREADS, 2) fwd(Params prm) {
    extern __shared__ __attribute__((aligned(16))) unsigned char lds_raw[];
    LAS unsigned char* lds = (LAS unsigned char*)lds_raw;
    for (int u = threadIdx.x; u < (LDS_BYTES - LDSCTL_OFF) / 4; u += NTHREADS) ((LAS unsigned*)(lds + LDSCTL_OFF))[u] = 0u;
    __syncthreads();
    XcdBarrier bar; bar.bar = (unsigned*)(prm.ws + WS_CTL) + CW_BAR; bar.x = 0; bar.st = nullptr;
    bar = xcd_barrier_post((unsigned*)(prm.ws + WS_CTL) + CW_BAR, (volatile LAS unsigned*)(lds + MISC_OFF) + 8);
#define PH_BEGIN {
#define PH_END   { XcdBarrier b2; b2.bar = (unsigned*)(get_args().ws() + WS_CTL) + CW_BAR; b2.x = bar.x; asm volatile("" : "+s"(b2.x)); b2.st = bar.st; xcd_barrier(b2); } }
    PH_BEGIN if (SEL(1)) phase_prologue(lds); PH_END
    for (int l = 0; l < 4; ++l) {
        if (l < 2) {
            PH_BEGIN if (SEL(6)) { gphase_hproj(lds, l); conv_drain(lds, 1, l == 0 ? CQ_H0 : (1 << 30), 2, l == 0 ? 0 : CQ_H1); } PH_END
            PH_BEGIN if (SEL(3)) { phase_gla_pre(lds, l); asm volatile("s_waitcnt vmcnt(0)" ::: "memory"); __builtin_amdgcn_fence(__ATOMIC_RELEASE, "workgroup"); __syncthreads(); __builtin_amdgcn_fence(__ATOMIC_ACQUIRE, "workgroup");
                gla_seq<false>(lds, l); phase_gla_sample(lds, l); } PH_END
            PH_BEGIN if (SEL(12)) gla_seq<true>(lds, l); PH_END
        } else {
            PH_BEGIN if (SEL(7)) { gphase_qkv(lds, l - 2); if (l == 2) conv_drain(lds, 2, 1 << 30, 3, CQ_Q0); } PH_END
            PH_BEGIN if (SEL(4)) phase_post(lds, l - 2); PH_END
            PH_BEGIN if (SEL(5)) { phase_attn_prompt(lds, l - 2); phase_attn_simple(lds, l - 2); } PH_END
        }
        PH_BEGIN if (SEL(8)) gphase_wo(lds, l); PH_END
        PH_BEGIN if (SEL(9)) { gphase_ffn1(lds, l); conv_drain(lds, l < 3 ? l + 1 : 3, l == 0 ? CQ_F0 : (l == 1 ? CQ_F1 : (l == 2 ? CQ_F2 : (1 << 30))), 0, 0); } PH_END
        PH_BEGIN if (SEL(10)) gphase_ffn2(lds, l); PH_END
    }
    { if (SEL(13)) phase_fix_sample(lds, 22); }
#undef PH_BEGIN
#undef PH_END
}

extern "C" void kernel_launch(void* const* d_in, const int* in_sizes, int n_in, void* d_out, int out_size, void* d_ws, size_t ws_size, hipStream_t stream) {
    static int ready = 0;
    if (ready == 0) {
        if (n_in != 26 || (size_t)out_size != O_END || ws_size < WS_END) { fprintf(stderr, "kernel_launch: unexpected shapes (n_in %d, out %d, ws %zu; need ws >= %zu)\n", n_in, out_size, ws_size, (size_t)WS_END); ready = -1; return; }
#if V1_SPLIT
        (void)hipFuncSetAttribute((const void*)k_gla, hipFuncAttributeMaxDynamicSharedMemorySize, LDS_BYTES); (void)hipFuncSetAttribute((const void*)k_attn, hipFuncAttributeMaxDynamicSharedMemorySize, LDS_BYTES);
#endif
        if (hipFuncSetAttribute((const void*)fwd, hipFuncAttributeMaxDynamicSharedMemorySize, LDS_BYTES) != hipSuccess) { fprintf(stderr, "kernel_launch: hipFuncSetAttribute failed\n"); ready = -1; return; }
        ready = 1;
    }
    if (ready < 0) return;
    (void)in_sizes;
    if (hipMemsetAsync((char*)d_ws + WS_CTL, 0, CTL_ZERO_BYTES, stream) != hipSuccess) return;
    Params p{};
    for (int i = 0; i < 26; ++i) p.in[i] = (const float*)d_in[i];
    p.out = (float*)d_out; p.ws = (unsigned char*)d_ws;
#if V1_SPLIT
    for (int ph = 0; ph < N_PHASES; ++ph) { p.lo = ph; p.hi = ph + 1;
        if (ph == 3 || ph == 10) { hipLaunchKernelGGL(k_gla, dim3(256), dim3(NTHREADS), LDS_BYTES, stream, p, ph == 3 ? 0 : 1); continue; }
        if (ph == 18 || ph == 26) { hipLaunchKernelGGL(k_attn, dim3(256), dim3(NTHREADS), LDS_BYTES, stream, p, ph == 18 ? 0 : 1); continue; }
        hipLaunchKernelGGL(fwd, dim3(256), dim3(NTHREADS), LDS_BYTES, stream, p); }
#else
    p.lo = 0; p.hi = N_PHASES;
    hipLaunchKernelGGL(fwd, dim3(256), dim3(NTHREADS), LDS_BYTES, stream, p);
#endif
}
```

```cpp
#include <hip/hip_runtime.h>
#include <cstdio>
#include <cstdint>

constexpr int NWAVES = 8, NTHREADS = 512;
constexpr int DM = 2048, DFF = 5632, TP = 4096, NBP = 2, NBS = 32, TS = 8;
constexpr int MP = NBP * TP  , MS = NBS * TS  , MROWS = MP + MS  ;
constexpr int NH = 16, DK = 128;
constexpr int NQH = 32, NKV = 8, HD = 64, KVW = NKV * HD  , WIN = 128;
constexpr int NPOS = TP + TS;
constexpr float RMS_EPS = 1e-6f;
constexpr size_t O_Y = 0, O_STP = (size_t)MROWS * DM, O_STS = O_STP + (size_t)2 * NBP * NH * DK * DK, O_KWP = O_STS + (size_t)2 * NBS * NH * DK * DK,
                 O_VWP = O_KWP + (size_t)NBP * WIN * KVW, O_KWS = O_VWP + (size_t)NBP * WIN * KVW, O_VWS = O_KWS + (size_t)NBS * WIN * KVW, O_END = O_VWS + (size_t)NBS * WIN * KVW;
static_assert(O_END == 39583744, "output size");
constexpr size_t MiB = 1u << 20;
constexpr size_t WS_CTL = 0, CTL_ZERO_BYTES = 1 * MiB;
constexpr size_t WS_LB = 1 * MiB, WS_ROPE = 1 * MiB + 65536;
constexpr size_t WS_WH = 4 * MiB, WS_WOH = WS_WH + 64 * MiB, WS_WQKV0 = WS_WOH + 16 * MiB, WS_WQ1 = WS_WQKV0 + 12 * MiB, WS_WOA = WS_WQ1 + 8 * MiB, WS_WGU = WS_WOA + 16 * MiB, WS_WD = WS_WGU + 176 * MiB;
constexpr size_t WS_H = WS_WD + 88 * MiB;
constexpr size_t WS_P = WS_H + 33 * MiB;
constexpr size_t WS_Q = WS_P, WS_KK = WS_P + 33 * MiB, WS_V = WS_P + 66 * MiB, WS_GT = WS_P + 99 * MiB, WS_LF = WS_P + 132 * MiB;
constexpr size_t WS_ACT = WS_P;
constexpr size_t WS_RAW = WS_P, WS_QF = WS_P + 99 * MiB, WS_KF = WS_P + 165 * MiB, WS_VF = WS_KF + (size_t)MROWS * KVW * 4;
constexpr size_t WS_OPS = WS_P + 198 * MiB, WS_SLOC = WS_OPS + 108 * MiB, WS_DSEG = WS_SLOC + 16 * MiB;
constexpr size_t WS_KC = WS_OPS, WS_VC = WS_OPS + 8 * MiB, WS_QC = WS_OPS + 16 * MiB;
constexpr size_t WS_SLAB = WS_DSEG + 1 * MiB;
constexpr size_t WS_XB = WS_SLAB + 64 * MiB;
constexpr size_t WS_RS = WS_XB + 33 * MiB;
constexpr size_t WS_XL = WS_RS + 1 * MiB;
constexpr size_t WS_END = WS_XL + 33 * MiB;
static_assert(WS_KK - WS_Q == 33 * MiB && WS_V - WS_Q == 66 * MiB && WS_GT - WS_Q == 99 * MiB, "EpiHproj addresses Q|KK|V|GT by type * 33 MiB");
static_assert(WS_ROPE + (size_t)NPOS * 32 * 8 <= WS_WH && WS_VF + (size_t)MROWS * KVW * 4 <= WS_OPS && (size_t)4096 * 27648 <= 108 * MiB && WS_ACT + (size_t)MROWS * DFF * 2 <= WS_KF, "ws map");
constexpr int CW_BAR = 4096, CW_TMO2 = 8000, CW_CNT = 8192, CW_Q = 12288;
constexpr int LDS_BYTES = 147456, LDSCTL_OFF = LDS_BYTES - 1024, MISC_OFF = LDSCTL_OFF + 320;

__device__ __forceinline__ float shx(float v, int k, int lane) { return __int_as_float(__builtin_amdgcn_ds_bpermute((lane ^ k) << 2, __float_as_int(v))); }
namespace pg8 {
#define PG8_LAS __attribute__((address_space(3)))
typedef unsigned short bf16_t;
typedef short bf16x8 __attribute__((ext_vector_type(8)));
typedef float f32x4 __attribute__((ext_vector_type(4)));
typedef unsigned u32x4 __attribute__((ext_vector_type(4)));
constexpr int BM = 256, BK = 64, HALF = 128, HTB = HALF * BK * 2  , STAGE_BYTES = 8 * HTB, NXCD = 8, WGM = 8;

__host__ __device__ __forceinline__ int lds_byte(int r, int c) { const int st = (r >> 4) * 2 + (c >> 5), rr = r & 15, cc = c & 31, ob = rr * 64 + cc * 2; return st * 1024 + (ob ^ (((ob >> 9) & 1) << 5)); }
__host__ __device__ __forceinline__ void stage_rc(int b, int& R, int& C) { const int st = b / 1024, sb = b % 1024, swz = sb ^ (((sb >> 9) & 1) << 5); R = (st >> 1) * 16 + swz / 64; C = (st & 1) * 32 + (swz % 64) / 2; }
__host__ __device__ __forceinline__ int perm32(int rho) { const int n = rho >> 4, i = rho & 15; return 8 * (i >> 2) + 4 * n + (i & 3); }

struct Unit { int pm, pn, k0, nt, ks; };
struct Gemm { const bf16_t* A; const bf16_t* Bt; int M, N, K; };

struct StaticOrder {
    int nM, nN, nwg, G, c, ntK;
    __host__ __device__ __forceinline__ void init(int M, int N, int K, int G_, int c_) { nM = M / BM; nN = N / BM; nwg = nM * nN; G = G_; c = c_; ntK = K / BK; }
    __host__ __device__ __forceinline__ bool next(int i, Unit& u) const {
        const int L = i * G + c; if (L >= nwg) return false;
        int wgid = (int)L; { const int q = nwg / NXCD, r = nwg % NXCD, xcd = wgid % NXCD, off = wgid / NXCD; wgid = (xcd < r ? xcd * (q + 1) : r * (q + 1) + (xcd - r) * q) + off; }
        const int nig = WGM * nN, gid = wgid / nig, fm = gid * WGM, gsz = (nM - fm) < WGM ? (nM - fm) : WGM;
        u.pm = fm + ((wgid % nig) % gsz); u.pn = (wgid % nig) / gsz; u.k0 = 0; u.nt = ntK; u.ks = -1; return true;
    }
    const unsigned* cnt; unsigned need; unsigned* tmo;
    __device__ __forceinline__ void a_ready(const Unit& u) const {
        if (u.pm == 32 && need != 0u) {
            if (__builtin_amdgcn_readfirstlane((int)threadIdx.x >> 6) == 0) {
                unsigned polls = 0;
                while ((unsigned)__builtin_amdgcn_readfirstlane(__hip_atomic_load(cnt, __ATOMIC_RELAXED, __HIP_MEMORY_SCOPE_AGENT)) < need) {
                    if (++polls > (1u << 20)) { if (threadIdx.x == 0) __hip_atomic_store(tmo, 1u, __ATOMIC_RELAXED, __HIP_MEMORY_SCOPE_AGENT); break; }
                    __builtin_amdgcn_s_sleep(2); }
                __builtin_amdgcn_fence(__ATOMIC_ACQUIRE, "agent");
                asm volatile("s_waitcnt vmcnt(0)" ::: "memory");
            }
            asm volatile("" ::: "memory"); __builtin_amdgcn_s_barrier(); asm volatile("" ::: "memory");
        }
    }
    __device__ __forceinline__ void done(const Unit&) const {}
};
struct SplitOrder {
    int nN, nP, nS, nTot, G, c, ntP, ntS, sfirst;
    __host__ __device__ __forceinline__ void init(int N, int K, int KS, int G_, int c_, int sfirst_ = 0) { nN = N / BM; nP = 32 * nN; nS = nN * KS; nTot = nP + nS; ntP = K / BK; ntS = ntP / KS; G = G_; c = c_; sfirst = sfirst_; }
    __host__ __device__ __forceinline__ bool next(int i, Unit& u) const {
        const int L = i * G + c; if (L >= nTot) return false;
        const bool isP = sfirst ? (L >= nS) : (L < nP); const int Lp = isP ? (sfirst ? L - nS : L) : 0, s = isP ? 0 : (sfirst ? L : L - nP);
        const int q = nP / NXCD, wgid = (Lp % NXCD) * q + Lp / NXCD, nig = WGM * nN;
        const int pmP = (wgid / nig) * WGM + ((wgid % nig) % WGM), pnP = (wgid % nig) / WGM, ksS = s / nN;
        u.pm = isP ? pmP : 32; u.pn = isP ? pnP : s - ksS * nN; u.ks = isP ? -1 : ksS; u.k0 = isP ? 0 : ksS * ntS * BK; u.nt = isP ? ntP : ntS;
        return true;
    }
    const unsigned* cnt; unsigned need; unsigned* tmo;
    __device__ __forceinline__ void a_ready(const Unit& u) const {
        if (u.pm == 32 && need != 0u) {
            if (__builtin_amdgcn_readfirstlane((int)threadIdx.x >> 6) == 0) {
                unsigned polls = 0;
                while ((unsigned)__builtin_amdgcn_readfirstlane(__hip_atomic_load(cnt, __ATOMIC_RELAXED, __HIP_MEMORY_SCOPE_AGENT)) < need) {
                    if (++polls > (1u << 20)) { if (threadIdx.x == 0) __hip_atomic_store(tmo, 1u, __ATOMIC_RELAXED, __HIP_MEMORY_SCOPE_AGENT); break; }
                    __builtin_amdgcn_s_sleep(2); }
                __builtin_amdgcn_fence(__ATOMIC_ACQUIRE, "agent");
                asm volatile("s_waitcnt vmcnt(0)" ::: "memory");
            }
            asm volatile("" ::: "memory"); __builtin_amdgcn_s_barrier(); asm volatile("" ::: "memory");
        }
    }
    __device__ __forceinline__ void done(const Unit&) const {}
};

#define PG8_GAS __attribute__((address_space(1)))
__device__ __forceinline__ unsigned cvt_pk_bf16(float lo, float hi) { unsigned r; asm volatile("v_cvt_pk_bf16_f32 %0, %1, %2" : "=v"(r) : "v"(lo), "v"(hi)); return r; }
__device__ __forceinline__ float silu_f(float a) { return a * __builtin_amdgcn_rcpf(1.0f + __expf(-a)); }
__device__ __forceinline__ u32x4 pack8(const f32x4 v0, const f32x4 v1) { u32x4 w; w.x = cvt_pk_bf16(v0[0], v0[1]); w.y = cvt_pk_bf16(v0[2], v0[3]); w.z = cvt_pk_bf16(v1[0], v1[1]); w.w = cvt_pk_bf16(v1[2], v1[3]); return w; }

struct NoState {};
struct RsState { float r[2]; };
__device__ __forceinline__ void rs_request(RsState& st, const float* RS, const Unit& u, int wr, int fr, int fq) { const int l = fr + 16 * fq; st.r[0] = ((const PG8_GAS float*)RS)[u.pm * BM + wr * 64 + l]; st.r[1] = ((const PG8_GAS float*)RS)[u.pm * BM + HALF + wr * 64 + l]; }
__device__ __forceinline__ float rstd_get(const RsState& st, int ai, int m, int fr) { const float v = __int_as_float(__builtin_amdgcn_ds_bpermute((16 * m + fr) << 2, __float_as_int(st.r[ai]))); return __builtin_amdgcn_rsqf(v * (1.0f / 2048.0f) + 1e-6f); }
struct EpiResid {
    static constexpr bool PERM = true, AFTER_DRAIN = false;
    typedef NoState State;
    const float* Xin32; float* Yout32; int ldc; float* slab; bf16_t* XB; bf16_t* XL; float* RS;
    __device__ __forceinline__ void init(f32x4 (&acc)[2][2][4][2], State&, const Unit& u, int wr, int wc, int fr, int fq) const {
        if (u.ks < 0) { const size_t off0 = (size_t)(u.pm * BM + wr * 64 + fr) * ldc + u.pn * BM + wc * 32 + 8 * fq;
            if (Xin32) {
#pragma unroll
                for (int a = 0; a < 2; ++a)
#pragma unroll
                    for (int b = 0; b < 2; ++b)
#pragma unroll
                        for (int m = 0; m < 4; ++m)
#pragma unroll
                            for (int n = 0; n < 2; ++n) acc[a][b][m][n] = *(const PG8_GAS f32x4*)((const PG8_GAS float*)Xin32 + off0 + (size_t)(a * HALF + m * 16) * ldc + b * HALF + 4 * n);
            } else {
#pragma unroll
                for (int a = 0; a < 2; ++a)
#pragma unroll
                    for (int b = 0; b < 2; ++b)
#pragma unroll
                        for (int m = 0; m < 4; ++m) { const size_t o = off0 + (size_t)(a * HALF + m * 16) * ldc + b * HALF;
                            const u32x4 h = *(const PG8_GAS u32x4*)((const PG8_GAS bf16_t*)XB + o), l = *(const PG8_GAS u32x4*)((const PG8_GAS bf16_t*)XL + o);
#pragma unroll
                            for (int k = 0; k < 4; ++k) { const float h0 = __uint_as_float(h[k] << 16), h1 = __uint_as_float(h[k] & 0xffff0000u), l0 = __uint_as_float(l[k] << 16), l1 = __uint_as_float(l[k] & 0xffff0000u);
                                acc[a][b][m][k >> 1][2 * (k & 1)] = h0 + l0; acc[a][b][m][k >> 1][2 * (k & 1) + 1] = h1 + l1; } }
            }
        } else {
#pragma unroll
            for (int a = 0; a < 2; ++a)
#pragma unroll
                for (int b = 0; b < 2; ++b)
#pragma unroll
                    for (int m = 0; m < 4; ++m)
#pragma unroll
                        for (int n = 0; n < 2; ++n) acc[a][b][m][n] = (f32x4){0.f, 0.f, 0.f, 0.f}; } }
    __device__ __forceinline__ void operator()(const f32x4 (&acc)[2][2][4][2], const State& st, const Unit& u, int wr, int wc, int fr_, int fq_) const {
        int fr = fr_, fq = fq_; asm volatile("" : "+v"(fr), "+v"(fq));
        const int row0 = u.pm * BM + wr * 64 + fr, col0 = u.pn * BM + wc * 32 + 8 * fq;
        if (u.ks >= 0) {
#pragma unroll
            for (int ai = 0; ai < 2; ++ai)
#pragma unroll
                for (int m = 0; m < 4; ++m) { PG8_GAS float* rowp = (PG8_GAS float*)slab + ((size_t)u.ks * BM + (wr * 64 + fr + ai * HALF + m * 16)) * ldc + col0;
#pragma unroll
                    for (int bj = 0; bj < 2; ++bj) { *(PG8_GAS f32x4*)(rowp + bj * HALF) = acc[ai][bj][m][0]; *(PG8_GAS f32x4*)(rowp + bj * HALF + 4) = acc[ai][bj][m][1]; } }
            return; }
        if (Yout32) {
#pragma unroll
            for (int ai = 0; ai < 2; ++ai)
#pragma unroll
                for (int m = 0; m < 4; ++m) { PG8_GAS float* rowp = (PG8_GAS float*)Yout32 + (size_t)(row0 + ai * HALF + m * 16) * ldc + col0;
#pragma unroll
                    for (int bj = 0; bj < 2; ++bj) { *(PG8_GAS f32x4*)(rowp + bj * HALF) = acc[ai][bj][m][0]; *(PG8_GAS f32x4*)(rowp + bj * HALF + 4) = acc[ai][bj][m][1]; } }
            return; }
#pragma unroll
        for (int ai = 0; ai < 2; ++ai)
#pragma unroll
            for (int m = 0; m < 4; ++m) { const size_t o = (size_t)(row0 + ai * HALF + m * 16) * ldc + col0; float ss = 0.f;
#pragma unroll
                for (int bj = 0; bj < 2; ++bj) { const f32x4 v0 = acc[ai][bj][m][0], v1 = acc[ai][bj][m][1];
                    ss += ((v0[0] * v0[0] + v0[1] * v0[1]) + (v0[2] * v0[2] + v0[3] * v0[3])) + ((v1[0] * v1[0] + v1[1] * v1[1]) + (v1[2] * v1[2] + v1[3] * v1[3]));
                    const u32x4 h = pack8(v0, v1); f32x4 r0, r1;
#pragma unroll
                    for (int k = 0; k < 2; ++k) { r0[2 * k] = v0[2 * k] - __uint_as_float(h[k] << 16); r0[2 * k + 1] = v0[2 * k + 1] - __uint_as_float(h[k] & 0xffff0000u);
                        r1[2 * k] = v1[2 * k] - __uint_as_float(h[2 + k] << 16); r1[2 * k + 1] = v1[2 * k + 1] - __uint_as_float(h[2 + k] & 0xffff0000u); }
                    *(PG8_GAS u32x4*)((PG8_GAS bf16_t*)XB + o + bj * HALF) = h; *(PG8_GAS u32x4*)((PG8_GAS bf16_t*)XL + o + bj * HALF) = pack8(r0, r1); }
                ss += shx(ss, 16, fr + 16 * fq); ss += shx(ss, 32, fr + 16 * fq);
                if (fq == 0) atomicAdd(RS + row0 + ai * HALF + m * 16, ss);
                asm volatile("" ::: "memory"); }
    }
};
struct EpiRaw {
    static constexpr bool PERM = true, AFTER_DRAIN = false;
    typedef RsState State;
    __device__ __forceinline__ void init(f32x4 (&acc)[2][2][4][2], State& st, const Unit& u, int wr, int wc, int fr, int fq) const { rs_request(st, RS, u, wr, fr, fq); (void)wc;
#pragma unroll
        for (int a = 0; a < 2; ++a)
#pragma unroll
            for (int b = 0; b < 2; ++b)
#pragma unroll
                for (int m = 0; m < 4; ++m)
#pragma unroll
                    for (int n = 0; n < 2; ++n) acc[a][b][m][n] = (f32x4){0.f, 0.f, 0.f, 0.f}; }
    bf16_t* C; int ldc; float* slab; const float* RS;
    __device__ __forceinline__ void operator()(const f32x4 (&acc)[2][2][4][2], const State& st, const Unit& u, int wr, int wc, int fr_, int fq_) const {
        int fr = fr_, fq = fq_; asm volatile("" : "+v"(fr), "+v"(fq));
        const int row0 = u.pm * BM + wr * 64 + fr, col0 = u.pn * BM + wc * 32 + 8 * fq;
        if (u.ks >= 0) {
#pragma unroll
            for (int ai = 0; ai < 2; ++ai)
#pragma unroll
                for (int m = 0; m < 4; ++m) { PG8_GAS float* rowp = (PG8_GAS float*)slab + ((size_t)u.ks * BM + (wr * 64 + fr + ai * HALF + m * 16)) * ldc + col0; const float rstd = rstd_get(st, ai, m, fr);
#pragma unroll
                    for (int bj = 0; bj < 2; ++bj) { *(PG8_GAS f32x4*)(rowp + bj * HALF) = acc[ai][bj][m][0] * rstd; *(PG8_GAS f32x4*)(rowp + bj * HALF + 4) = acc[ai][bj][m][1] * rstd; } }
            return; }
#pragma unroll
        for (int ai = 0; ai < 2; ++ai)
#pragma unroll
            for (int m = 0; m < 4; ++m) { PG8_GAS bf16_t* rowp = (PG8_GAS bf16_t*)C + (size_t)(row0 + ai * HALF + m * 16) * ldc + col0; const float rstd = rstd_get(st, ai, m, fr);
#pragma unroll
                for (int bj = 0; bj < 2; ++bj) *(PG8_GAS u32x4*)(rowp + bj * HALF) = pack8(acc[ai][bj][m][0] * rstd, acc[ai][bj][m][1] * rstd); }
    }
};
struct EpiFfn1 {
    static constexpr bool PERM = true, AFTER_DRAIN = false;
    typedef RsState State;
    __device__ __forceinline__ void init(f32x4 (&acc)[2][2][4][2], State& st, const Unit& u, int wr, int wc, int fr, int fq) const { rs_request(st, RS, u, wr, fr, fq); (void)wc;
#pragma unroll
        for (int a = 0; a < 2; ++a)
#pragma unroll
            for (int b = 0; b < 2; ++b)
#pragma unroll
                for (int m = 0; m < 4; ++m)
#pragma unroll
                    for (int n = 0; n < 2; ++n) acc[a][b][m][n] = (f32x4){0.f, 0.f, 0.f, 0.f}; }
    bf16_t* O; int ldc; const float* RS;
    __device__ __forceinline__ void operator()(const f32x4 (&acc)[2][2][4][2], const State& st, const Unit& u, int wr, int wc, int fr_, int fq_) const {
        int fr = fr_, fq = fq_; asm volatile("" : "+v"(fr), "+v"(fq));
        const int row0 = u.pm * BM + wr * 64 + fr, col0 = u.pn * HALF + wc * 32 + 8 * fq;
#pragma unroll
        for (int ai = 0; ai < 2; ++ai)
#pragma unroll
            for (int m = 0; m < 4; ++m) { PG8_GAS bf16_t* rowp = (PG8_GAS bf16_t*)O + (size_t)(row0 + ai * HALF + m * 16) * ldc + col0;
                f32x4 v0, v1; const float rstd = rstd_get(st, ai, m, fr);
#pragma unroll
                for (int e = 0; e < 4; ++e) { v0[e] = silu_f(acc[ai][0][m][0][e] * rstd) * (acc[ai][1][m][0][e] * rstd); v1[e] = silu_f(acc[ai][0][m][1][e] * rstd) * (acc[ai][1][m][1][e] * rstd); }
                *(PG8_GAS u32x4*)rowp = pack8(v0, v1); }
    }
};
struct EpiHproj {
    static constexpr bool PERM = true, AFTER_DRAIN = false;
    typedef RsState State;
    __device__ __forceinline__ void init(f32x4 (&acc)[2][2][4][2], State& st, const Unit& u, int wr, int wc, int fr, int fq) const { rs_request(st, (const float*)(ws + WS_RS) + MROWS, u, wr, fr, fq); (void)wc;
#pragma unroll
        for (int a = 0; a < 2; ++a)
#pragma unroll
            for (int b = 0; b < 2; ++b)
#pragma unroll
                for (int m = 0; m < 4; ++m)
#pragma unroll
                    for (int n = 0; n < 2; ++n) acc[a][b][m][n] = (f32x4){0.f, 0.f, 0.f, 0.f}; }
    unsigned char* ws; int l;
    __device__ __forceinline__ void operator()(const f32x4 (&acc)[2][2][4][2], const State& st, const Unit& u, int wr, int wc, int fr_, int fq_) const {
        int fr = fr_, fq = fq_; asm volatile("" : "+v"(fr), "+v"(fq));
        bf16_t* const Q = (bf16_t*)(ws + WS_Q); float* const LF = (float*)(ws + WS_LF); const float* const lb = (const float*)(ws + WS_LB) + l * 2048; float* const slab = (float*)(ws + WS_SLAB);
        const int row0 = u.pm * BM + wr * 64 + fr; const int type = u.pn >> 3; const int col0 = (u.pn & 7) * BM + wc * 32 + 8 * fq;
        if (u.ks >= 0) {
#pragma unroll
            for (int ai = 0; ai < 2; ++ai)
#pragma unroll
                for (int m = 0; m < 4; ++m) { const float rstd = rstd_get(st, ai, m, fr); PG8_GAS float* rowp = (PG8_GAS float*)slab + ((size_t)u.ks * BM + (wr * 64 + fr + ai * HALF + m * 16)) * 8192 + u.pn * BM + wc * 32 + 8 * fq;
#pragma unroll
                    for (int bj = 0; bj < 2; ++bj) { *(PG8_GAS f32x4*)(rowp + bj * HALF) = acc[ai][bj][m][0] * rstd; *(PG8_GAS f32x4*)(rowp + bj * HALF + 4) = acc[ai][bj][m][1] * rstd; } }
            return; }
        if (type == 1) {
#pragma unroll
            for (int bj = 0; bj < 2; ++bj) {
                const f32x4 lb0 = *(const PG8_GAS f32x4*)((const PG8_GAS float*)lb + col0 + bj * HALF), lb1 = *(const PG8_GAS f32x4*)((const PG8_GAS float*)lb + col0 + bj * HALF + 4);
#pragma unroll
                for (int ai = 0; ai < 2; ++ai)
#pragma unroll
                    for (int m = 0; m < 4; ++m) { const size_t off = (size_t)(row0 + ai * HALF + m * 16) * 2048 + col0 + bj * HALF; const float rstd = rstd_get(st, ai, m, fr);
#pragma unroll
                        for (int n = 0; n < 2; ++n) { f32x4 lf;
#pragma unroll
                            for (int e = 0; e < 4; ++e) { float z = acc[ai][bj][m][n][e] * rstd; z = fminf(fmaxf(z, -80.f), 80.f); const float ex = __expf(-z), s = __builtin_amdgcn_rcpf(1.0f + ex), l = n ? lb1[e] : lb0[e];
                                const float f = l + (1.0f - l) * s; lf[e] = __logf(fmaxf(f, 1e-30f)); }
                            *(PG8_GAS f32x4*)((PG8_GAS float*)LF + off + 4 * n) = lf; } } }
        } else {
            PG8_GAS bf16_t* dst = (PG8_GAS bf16_t*)Q + (size_t)type * ((size_t)33 << 19);
#pragma unroll
            for (int ai = 0; ai < 2; ++ai)
#pragma unroll
                for (int m = 0; m < 4; ++m) { const size_t off = (size_t)(row0 + ai * HALF + m * 16) * 2048 + col0; const float rstd = rstd_get(st, ai, m, fr);
#pragma unroll
                    for (int bj = 0; bj < 2; ++bj) { f32x4 v0 = acc[ai][bj][m][0] * rstd, v1 = acc[ai][bj][m][1] * rstd;
                        if (type == 0) {
#pragma unroll
                            for (int e = 0; e < 4; ++e) { v0[e] = silu_f(v0[e]) * 0.08838834764831845f; v1[e] = silu_f(v1[e]) * 0.08838834764831845f; } }
                        else if (type == 3) {
#pragma unroll
                            for (int e = 0; e < 4; ++e) { v0[e] = silu_f(v0[e]); v1[e] = silu_f(v1[e]); } }
                        *(PG8_GAS u32x4*)(dst + off + bj * HALF) = pack8(v0, v1); } }
        }
    }
};
template <class Epi, class Sched, bool ALIGN_EPI = false, bool SP2 = false>
__device__ __forceinline__ void gemm_phase(PG8_LAS unsigned char* lds, const Gemm g, const Sched& S, const Epi& E, const int tid) {
    const int wid = __builtin_amdgcn_readfirstlane(tid >> 6), lane = tid & 63, wr = wid >> 2, wc = wid & 3, fr = lane & 15, fq = lane >> 4;
    const int K = g.K;
    unsigned voffA[2], voffB[2];
#pragma unroll
    for (int i = 0; i < 2; ++i) { int R, C; stage_rc(tid * 16 + i * 8192, R, C); const int Rb = Epi::PERM ? ((R & ~31) + perm32(R & 31)) : R;
        voffA[i] = (unsigned)(R * K + C) * 2u; voffB[i] = (unsigned)(Rb * K + C) * 2u; }
    const size_t kstep = (size_t)(BK * 2);
    const size_t hstep = (size_t)HALF * K * 2;
    const size_t tstep = 2 * hstep;
    const unsigned ldsw = (unsigned)wid * 1024u;
    const int aoff = lds_byte(wr * 64 + fr, fq * 8), boff = lds_byte(wc * 32 + fr, fq * 8);
#define PG8_SA(b, h) (((b) * 2 + (h)) * HTB)
#define PG8_SB(b, h) ((4 + (b) * 2 + (h)) * HTB)
#define PG8_STAGE(bufoff, gbase, voff) do { _Pragma("unroll") for (int _i = 0; _i < 2; ++_i) \
        __builtin_amdgcn_global_load_lds((const unsigned*)((const char*)(gbase) + (voff)[_i]), (PG8_LAS unsigned*)(lds + (bufoff) + ldsw + _i * 8192), 16, 0, 0); } while (0)
#define PG8_LDA(dst, b, h) do { _Pragma("unroll") for (int m = 0; m < 4; ++m) _Pragma("unroll") for (int k = 0; k < 2; ++k) dst[m][k] = *(const PG8_LAS bf16x8*)(lds + PG8_SA(b, h) + aoff + m * 2048 + k * 1024); } while (0)
#define PG8_LDB(dst, b, h) do { _Pragma("unroll") for (int n = 0; n < 2; ++n) _Pragma("unroll") for (int k = 0; k < 2; ++k) dst[n][k] = *(const PG8_LAS bf16x8*)(lds + PG8_SB(b, h) + boff + n * 2048 + k * 1024); } while (0)
#define PG8_MMA(ai, bj, At, Bt) do { __builtin_amdgcn_s_setprio(1); _Pragma("unroll") for (int m = 0; m < 4; ++m) _Pragma("unroll") for (int n = 0; n < 2; ++n) _Pragma("unroll") for (int k = 0; k < 2; ++k) \
        acc[ai][bj][m][n] = __builtin_amdgcn_mfma_f32_16x16x32_bf16(Bt[n][k], At[m][k], acc[ai][bj][m][n], 0, 0, 0); __builtin_amdgcn_s_setprio(0); } while (0)
#define PG8_WAIT_V(n) asm volatile("s_waitcnt vmcnt(" #n ")" ::: "memory")
#define PG8_WAIT_L(n) asm volatile("s_waitcnt lgkmcnt(" #n ")" ::: "memory")
#define PG8_BAR __builtin_amdgcn_s_barrier()
#define PG8_SCHED __builtin_amdgcn_sched_barrier(0)
    Unit cur, nxt; int ui = 0;
    if (!S.next(0, cur)) return;
    f32x4 acc[2][2][4][2];
    typename Epi::State est;
    E.init(acc, est, cur, wr, wc, fr, fq);
    bf16x8 At[4][2], B0[2][2], B1[2][2];
    const char* cA = (const char*)g.A + (size_t)cur.pm * tstep + (size_t)cur.k0 * 2; const char* cB = (const char*)g.Bt + (size_t)cur.pn * tstep + (size_t)cur.k0 * 2;
    S.a_ready(cur);
    if constexpr (SP2) {
        PG8_STAGE(PG8_SB(0, 0), cB, voffB); PG8_STAGE(PG8_SB(0, 1), cB + hstep, voffB); PG8_STAGE(PG8_SA(0, 0), cA, voffA); PG8_STAGE(PG8_SA(0, 1), cA + hstep, voffA);
        if (wr == 1) PG8_BAR;
        PG8_WAIT_V(2); PG8_BAR;
        PG8_STAGE(PG8_SB(1, 0), cB + kstep, voffB); PG8_STAGE(PG8_SA(1, 0), cA + kstep, voffA); PG8_STAGE(PG8_SB(1, 1), cB + hstep + kstep, voffB);
        PG8_WAIT_V(6); PG8_BAR;
    } else {
        PG8_STAGE(PG8_SB(0, 0), cB, voffB); PG8_STAGE(PG8_SA(0, 0), cA, voffA); PG8_STAGE(PG8_SB(0, 1), cB + hstep, voffB); PG8_STAGE(PG8_SA(0, 1), cA + hstep, voffA);
        if (wr == 1) PG8_BAR;
        PG8_WAIT_V(4); PG8_BAR;
        PG8_STAGE(PG8_SB(1, 0), cB + kstep, voffB); PG8_STAGE(PG8_SA(1, 0), cA + kstep, voffA); PG8_STAGE(PG8_SB(1, 1), cB + hstep + kstep, voffB);
        PG8_WAIT_V(6); PG8_BAR;
    }
    for (;;) {
        const bool has_next = S.next(ui + 1, nxt);
        const char* nA = has_next ? (const char*)g.A + (size_t)nxt.pm * tstep + (size_t)nxt.k0 * 2 : cA; const char* nB = has_next ? (const char*)g.Bt + (size_t)nxt.pn * tstep + (size_t)nxt.k0 * 2 : cB;
        const int nt = cur.nt;
        for (int t = 0; t < nt; t += 2) {
            const bool last = (t == nt - 2);
            const char* a1 = cA + (size_t)(t + 1) * kstep;
            const char* a2 = last ? nA : cA + (size_t)(t + 2) * kstep; const char* b2 = last ? nB : cB + (size_t)(t + 2) * kstep;
            const char* a3 = a2 + kstep; const char* b3 = b2 + kstep;
            if (last && has_next) S.a_ready(nxt);
            if constexpr (SP2) {
            PG8_LDB(B0, 0, 0); PG8_LDB(B1, 0, 1); PG8_SCHED; PG8_LDA(At, 0, 0); PG8_STAGE(PG8_SA(1, 1), a1 + hstep, voffA);
            PG8_WAIT_V(8); PG8_WAIT_L(0); PG8_BAR; PG8_MMA(0, 0, At, B0); PG8_MMA(0, 1, At, B1); PG8_BAR; PG8_SCHED;
            PG8_LDA(At, 0, 1); PG8_STAGE(PG8_SB(0, 0), b2, voffB); PG8_STAGE(PG8_SB(0, 1), b2 + hstep, voffB); PG8_STAGE(PG8_SA(0, 0), a2, voffA);
            PG8_WAIT_V(8); PG8_WAIT_L(0); PG8_BAR; PG8_MMA(1, 0, At, B0); PG8_MMA(1, 1, At, B1); PG8_BAR; PG8_SCHED;
            PG8_LDB(B0, 1, 0); PG8_LDB(B1, 1, 1); PG8_SCHED; PG8_LDA(At, 1, 0); PG8_STAGE(PG8_SA(0, 1), a2 + hstep, voffA);
            PG8_WAIT_V(8); PG8_WAIT_L(0); PG8_BAR; PG8_MMA(0, 0, At, B0); PG8_MMA(0, 1, At, B1); PG8_BAR; PG8_SCHED;
            PG8_LDA(At, 1, 1); PG8_STAGE(PG8_SB(1, 0), b3, voffB); PG8_STAGE(PG8_SB(1, 1), b3 + hstep, voffB); PG8_STAGE(PG8_SA(1, 0), a3, voffA);
            PG8_WAIT_V(8); PG8_WAIT_L(0); PG8_BAR; PG8_MMA(1, 0, At, B0); PG8_MMA(1, 1, At, B1); PG8_BAR; PG8_SCHED;
            } else {
            PG8_LDB(B0, 0, 0); PG8_SCHED; PG8_LDA(At, 0, 0); PG8_STAGE(PG8_SA(1, 1), a1 + hstep, voffA);
            PG8_WAIT_L(8); PG8_BAR; PG8_WAIT_L(0); PG8_MMA(0, 0, At, B0); PG8_BAR; PG8_SCHED;
            PG8_LDB(B1, 0, 1); PG8_STAGE(PG8_SB(0, 0), b2, voffB);
            PG8_BAR; PG8_WAIT_L(0); PG8_MMA(0, 1, At, B1); PG8_BAR;
            PG8_LDA(At, 0, 1); PG8_STAGE(PG8_SA(0, 0), a2, voffA);
            PG8_BAR; PG8_WAIT_L(0); PG8_MMA(1, 0, At, B0); PG8_BAR; PG8_SCHED;
            PG8_STAGE(PG8_SB(0, 1), b2 + hstep, voffB);
            PG8_WAIT_V(6); PG8_BAR; PG8_MMA(1, 1, At, B1); PG8_BAR;
            PG8_LDB(B0, 1, 0); PG8_SCHED; PG8_LDA(At, 1, 0); PG8_STAGE(PG8_SA(0, 1), a2 + hstep, voffA);
            PG8_WAIT_L(8); PG8_BAR; PG8_WAIT_L(0); PG8_MMA(0, 0, At, B0); PG8_BAR; PG8_SCHED;
            PG8_LDB(B1, 1, 1); PG8_STAGE(PG8_SB(1, 0), b3, voffB);
            PG8_BAR; PG8_WAIT_L(0); PG8_MMA(0, 1, At, B1); PG8_BAR;
            PG8_LDA(At, 1, 1); PG8_STAGE(PG8_SA(1, 0), a3, voffA);
            PG8_BAR; PG8_WAIT_L(0); PG8_MMA(1, 0, At, B0); PG8_BAR; PG8_SCHED;
            PG8_STAGE(PG8_SB(1, 1), b3 + hstep, voffB);
            PG8_WAIT_V(6); PG8_BAR; PG8_MMA(1, 1, At, B1); PG8_BAR;
            }
        }
        if constexpr (ALIGN_EPI) { if (wr == 0) PG8_BAR; }
        if constexpr (!Epi::AFTER_DRAIN) { E(acc, est, cur, wr, wc, fr, fq); S.done(cur); }
        if (!has_next) break;
        E.init(acc, est, nxt, wr, wc, fr, fq);
        cur = nxt; cA = nA; cB = nB; ++ui;
        if constexpr (ALIGN_EPI) { if (wr == 1) PG8_BAR; }
    }
    PG8_WAIT_V(0);
    if constexpr (!ALIGN_EPI) { if (wr == 0) PG8_BAR; }
    PG8_BAR;
    if constexpr (Epi::AFTER_DRAIN) { E.fused(acc, cur, wr, wc, fr, fq, lds, wid, lane); S.done(cur); }
#undef PG8_SA
#undef PG8_SB
#undef PG8_STAGE
#undef PG8_LDA
#undef PG8_LDB
#undef PG8_MMA
#undef PG8_WAIT_V
#undef PG8_WAIT_L
#undef PG8_BAR
#undef PG8_SCHED
}
}
#define LAS __attribute__((address_space(3)))
typedef unsigned short bf16;
typedef float f32x4 __attribute__((ext_vector_type(4)));
typedef float f32x2 __attribute__((ext_vector_type(2)));
typedef unsigned u32x4 __attribute__((ext_vector_type(4)));
typedef unsigned u32x2 __attribute__((ext_vector_type(2)));
typedef short bf16x8 __attribute__((ext_vector_type(8)));
typedef float f32x16 __attribute__((ext_vector_type(16)));
#define GAS __attribute__((address_space(1)))
__device__ __forceinline__ unsigned pk_bf16(float lo, float hi) { return pg8::cvt_pk_bf16(lo, hi); }
__device__ __forceinline__ float bf2f(unsigned short b) { return __uint_as_float(((unsigned)b) << 16); }
__device__ __forceinline__ float wave_sum(float v, int lane) {
#pragma unroll
    for (int o = 1; o < 64; o <<= 1) v += shx(v, o, lane);
    return v;
}
__device__ __forceinline__ float wave_max(float v, int lane) {
#pragma unroll
    for (int o = 1; o < 64; o <<= 1) v = fmaxf(v, shx(v, o, lane));
    return v;
}
#define XB_TMO      128
#define XB_XCNT(j)  (256  + 64 * (j))
#define XB_XSUB(j)  (1280 + 64 * (j))
#define XB_XGEN(j)  (2304 + 64 * (j))
#define XB_TOP      3328
#define XB_TOPGEN   3392
#define XCD_BAR_WORDS 3456
#define XB_SPIN_CAP (1u << 18)

__device__ __forceinline__ unsigned xb_ld(unsigned* p)              { return __hip_atomic_load(p, __ATOMIC_RELAXED, __HIP_MEMORY_SCOPE_AGENT); }
__device__ __forceinline__ unsigned xb_add(unsigned* p, unsigned v) { return __hip_atomic_fetch_add(p, v, __ATOMIC_RELAXED, __HIP_MEMORY_SCOPE_AGENT); }
__device__ __forceinline__ unsigned xb_xcc_id() { return (unsigned)__builtin_amdgcn_s_getreg((3 << 11) | 20) & 0xFu; }
#define XB_SPIN(cond, bar) do { unsigned _sp = 0; while (cond) { __builtin_amdgcn_s_sleep(1); \
    if ((++_sp & 255u) == 0u) { if (xb_ld(&(bar)[XB_TMO])) break; if (_sp > XB_SPIN_CAP) { atomicAdd(&(bar)[XB_TMO], 1u); break; } } } } while (0)

struct XcdBarrier {
    unsigned* bar; unsigned x;
    volatile LAS unsigned* st;
};

__device__ __forceinline__ XcdBarrier xcd_barrier_post(unsigned* bar, volatile LAS unsigned* st) {
    XcdBarrier b; b.bar = bar; b.x = xb_xcc_id(); b.st = st;
    if (threadIdx.x == 0) (void)xb_add(&bar[XB_XCNT(b.x)], 1u);
    return b;
}
__device__ __forceinline__ void xcd_barrier_complete(unsigned* bar, unsigned x, unsigned& nloc, unsigned& nx) {
    const unsigned G = gridDim.x * gridDim.y * gridDim.z;
    unsigned sum, cnt, mine, sp = 0u;
    for (;;) {
        sum = 0u; cnt = 0u; mine = 0u;
#pragma unroll
        for (unsigned j = 0; j < 16; ++j) { const unsigned c = xb_ld(&bar[XB_XCNT(j)]); sum += c; cnt += (c > 0u) ? 1u : 0u; mine = (j == x) ? c : mine; }
        if (sum == G) break;
        __builtin_amdgcn_s_sleep(1);
        if ((++sp & 255u) == 0u) { if (xb_ld(&bar[XB_TMO])) break; if (sp > XB_SPIN_CAP) { atomicAdd(&bar[XB_TMO], 1u); break; } }
    }
    nloc = mine > 0u ? mine : 1u; nx = cnt > 0u ? cnt : 1u;
}

__device__ __forceinline__ void xcd_barrier(const XcdBarrier& b) {
    asm volatile("s_waitcnt vmcnt(0)" ::: "memory");
    __syncthreads();
    if (threadIdx.x == 0) {
        unsigned* bar = b.bar;
        __builtin_amdgcn_s_waitcnt(0);
        unsigned nloc = b.st[0], nx = b.st[1];
        if (nloc == 0u) { xcd_barrier_complete(bar, b.x, nloc, nx); b.st[0] = nloc; b.st[1] = nx; }
        const unsigned old = xb_add(&bar[XB_XSUB(b.x)], 1u);
        const unsigned gen = old / nloc;
        if (old + 1u == (gen + 1u) * nloc) {
            __builtin_amdgcn_fence(__ATOMIC_RELEASE, "agent");
            asm volatile("s_waitcnt vmcnt(0)" ::: "memory");
            const unsigned og = xb_add(&bar[XB_TOP], 1u);
            const unsigned tg = og / nx;
            if (og + 1u == (tg + 1u) * nx) xb_add(&bar[XB_TOPGEN], 1u);
            else XB_SPIN(xb_ld(&bar[XB_TOPGEN]) == tg, bar);
            __builtin_amdgcn_fence(__ATOMIC_ACQUIRE, "agent");
            xb_add(&bar[XB_XGEN(b.x)], 1u);
            asm volatile("s_waitcnt vmcnt(0)" ::: "memory");
        } else {
            XB_SPIN(xb_ld(&bar[XB_XGEN(b.x)]) == gen, bar);
            __builtin_amdgcn_fence(__ATOMIC_ACQUIRE, "agent");
            asm volatile("s_waitcnt vmcnt(0)" ::: "memory");
        }
    }
    __syncthreads();
}

struct Params { const float* in[26]; float* out; unsigned char* ws; int lo, hi; };
struct Frame { LAS unsigned char* lds; int tid, lane, wave, G, gw, NGW; };
#define CAS __attribute__((address_space(4)))
struct Args { const unsigned char CAS* k;
    __device__ __forceinline__ const float* in(int i) const { return *(const float* const CAS*)(k + 8 * i); }
    __device__ __forceinline__ float* out() const { return *(float* const CAS*)(k + 8 * 26); }
    __device__ __forceinline__ unsigned char* ws() const { return *(unsigned char* const CAS*)(k + 8 * 27); } };
__device__ __forceinline__ Args get_args() { Args a; a.k = (const unsigned char CAS*)__builtin_amdgcn_kernarg_segment_ptr(); asm volatile("" : "+s"(a.k)); return a; }
__device__ __forceinline__ Frame make_frame(LAS unsigned char* lds) { Frame F; int tid = threadIdx.x; asm volatile("" : "+v"(tid)); F.lds = lds; F.tid = tid; F.lane = tid & 63; F.wave = __builtin_amdgcn_readfirstlane(tid >> 6); F.G = gridDim.x;
    F.gw = blockIdx.x * NWAVES + F.wave; F.NGW = F.G * NWAVES; return F; }
#define LDS_WAIT() asm volatile("s_waitcnt lgkmcnt(0)" ::: "memory")
enum { I_XP = 0, I_XS, I_ST, I_CK, I_CV, I_HNORM, I_HWQ, I_HWF, I_HWI, I_HWG, I_LBL, I_ONORM, I_HWO, I_KVNORM, I_WK, I_WV, I_KNORM, I_ANORM, I_AWQ, I_QNORM, I_SINKS, I_AWO, I_FNORM, I_WG, I_WU, I_WDN };

struct CDesc { const float* W; const float* g; bf16* dst; int K, N, mode, row_off, k0, n0; };
__device__ __forceinline__ void conv_load(const CDesc& d, f32x4 (&v)[16], float& gv, int lane) {
    const int c4 = lane & 15, r4 = lane >> 4;
#pragma unroll
    for (int i = 0; i < 16; ++i) v[i] = __builtin_nontemporal_load((const GAS f32x4*)((const GAS float*)d.W + (size_t)(d.k0 + 4 * i + r4) * d.N + d.n0 + 4 * c4));
    gv = d.g ? ((const GAS float*)d.g)[d.k0 + lane] : 1.0f;
}
__device__ __forceinline__ void conv_finish(const CDesc& d, f32x4 (&v)[16], float gv, LAS float* scr, int lane) {
    const int c4 = lane & 15, r4 = lane >> 4;
#pragma unroll
    for (int i = 0; i < 16; ++i) { const float gs = __int_as_float(__builtin_amdgcn_ds_bpermute((4 * i + r4) << 2, __float_as_int(gv)));
#pragma unroll
        for (int e = 0; e < 4; ++e) scr[(4 * c4 + e) * 65 + 4 * i + r4] = v[i][e] * gs; }
    LDS_WAIT();
    const int c = lane & 7;
    const int drow0 = (d.mode == 0) ? (d.row_off + d.n0) : ((d.n0 >> 7) * 256 + (d.n0 & 127) + (d.mode == 2 ? 128 : 0));
#pragma unroll
    for (int jn = 0; jn < 8; ++jn) { const int n = jn * 8 + (lane >> 3); const LAS float* s = scr + n * 65 + 8 * c;
        u32x4 o; o.x = pg8::cvt_pk_bf16(s[0], s[1]); o.y = pg8::cvt_pk_bf16(s[2], s[3]); o.z = pg8::cvt_pk_bf16(s[4], s[5]); o.w = pg8::cvt_pk_bf16(s[6], s[7]);
        __builtin_nontemporal_store(o, (GAS u32x4*)((GAS bf16*)d.dst + (size_t)(drow0 + n) * d.K + d.k0 + 8 * c)); }
    LDS_WAIT();
}
__host__ __device__ constexpr int conv_items(int L) { return L < 2 ? 5 * 1024 + 3 * 2816 : (L == 2 ? 2 * 256 + 2 * 1024 + 3 * 2816 : 2 * 1024 + 3 * 2816); }
__device__ __forceinline__ CDesc conv_desc(const Args& p, unsigned char* ws, int L, int idx) {
    constexpr int SQ = 2048 * 2048;
    const float* W; const float* g = nullptr; bf16* dst; int K = 2048, N = 2048, mode = 0, row_off = 0, loc; const int nproj = conv_items(L) - 3 * 2816;
    if (idx >= nproj) { const int r = idx - nproj, kind = r / 2816; loc = r - kind * 2816;
        if (kind == 0) { W = p.in(I_WG) + (size_t)L * DM * DFF; g = p.in(I_FNORM) + L * DM; dst = (bf16*)(ws + WS_WGU) + (size_t)L * 2 * DFF * DM; N = DFF; mode = 1; }
        else if (kind == 1) { W = p.in(I_WU) + (size_t)L * DM * DFF; g = p.in(I_FNORM) + L * DM; dst = (bf16*)(ws + WS_WGU) + (size_t)L * 2 * DFF * DM; N = DFF; mode = 2; }
        else { W = p.in(I_WDN) + (size_t)L * DM * DFF; dst = (bf16*)(ws + WS_WD) + (size_t)L * DM * DFF; K = DFF; N = DM; } }
    else if (L < 2) { const int jid = idx >> 10; loc = idx & 1023;
        if (jid < 4) { W = p.in(I_HWQ + jid) + (size_t)L * SQ; g = p.in(I_HNORM) + L * DM; dst = (bf16*)(ws + WS_WH) + (size_t)L * 8192 * 2048; row_off = jid * 2048; }
        else { W = p.in(I_HWO) + (size_t)L * SQ; dst = (bf16*)(ws + WS_WOH) + (size_t)L * SQ; } }
    else if (L == 2) {
        if (idx < 512) { const int w = idx >> 8; loc = idx & 255; N = 512; W = p.in(w ? I_WV : I_WK); g = p.in(I_KVNORM); dst = (bf16*)(ws + WS_WQKV0); row_off = w * 512; }
        else if (idx < 512 + 1024) { loc = idx - 512; W = p.in(I_AWQ); g = p.in(I_ANORM); dst = (bf16*)(ws + WS_WQKV0); row_off = 1024; }
        else { loc = idx - 1536; W = p.in(I_AWO); dst = (bf16*)(ws + WS_WOA); } }
    else { if (idx < 1024) { loc = idx; W = p.in(I_AWQ) + SQ; g = p.in(I_ANORM) + DM; dst = (bf16*)(ws + WS_WQ1); }
        else { loc = idx - 1024; W = p.in(I_AWO) + SQ; dst = (bf16*)(ws + WS_WOA) + SQ; } }
    const int nblk = N / 64, kb = loc / nblk, nb = loc - kb * nblk;
    return CDesc{W, g, dst, K, N, mode, row_off, 64 * kb, 64 * nb};
}
#ifndef CQ_H0
#define CQ_H0 8700
#define CQ_F0 12000
#define CQ_H1 7100
#define CQ_F1 10400
#define CQ_Q0 4400
#define CQ_F2 7680
#endif
__device__ __forceinline__ void conv_drain(LAS unsigned char* lds, int La, int qa, int Lb, int qb) {
    const Args p = get_args(); Frame F = make_frame(lds); unsigned char* ws = p.ws(); LAS float* scr = (LAS float*)(F.lds + F.wave * 16640);
    for (int r = 0; r < 2; ++r) { const int L = r ? Lb : La, quota = r ? qb : qa; if (quota <= 0) continue;
        unsigned* qc = (unsigned*)(ws + WS_CTL) + CW_Q + 64 * L; const int n = conv_items(L), lim = quota < n ? quota : n;
        for (;;) { int base = n;
            if (F.lane == 0) { if ((int)__hip_atomic_load(qc, __ATOMIC_RELAXED, __HIP_MEMORY_SCOPE_AGENT) < lim) base = (int)__hip_atomic_fetch_add(qc, 4u, __ATOMIC_RELAXED, __HIP_MEMORY_SCOPE_AGENT); }
            base = __builtin_amdgcn_readfirstlane(base);
            if (base >= n) break;
            f32x4 va[16], vb[16]; float ga, gb;
            CDesc da = conv_desc(p, ws, L, base), db = conv_desc(p, ws, L, base + 1); conv_load(da, va, ga, F.lane); conv_load(db, vb, gb, F.lane);
            conv_finish(da, va, ga, scr, F.lane); da = conv_desc(p, ws, L, base + 2); conv_load(da, va, ga, F.lane);
            conv_finish(db, vb, gb, scr, F.lane); db = conv_desc(p, ws, L, base + 3); conv_load(db, vb, gb, F.lane);
            conv_finish(da, va, ga, scr, F.lane); conv_finish(db, vb, gb, scr, F.lane); } }
}
__device__ __forceinline__ void phase_prologue(LAS unsigned char* lds) {
    const Args p = get_args(); Frame F = make_frame(lds); unsigned char* ws = p.ws(); LAS float* scr = (LAS float*)(F.lds + F.wave * 16640);
    { constexpr int n = conv_items(0); int it = F.gw;
      if (it < n) { f32x4 va[16], vb[16]; float ga, gb; CDesc da = conv_desc(p, ws, 0, it), db = da; conv_load(da, va, ga, F.lane);
        for (;;) { const int i1 = it + F.NGW; if (i1 < n) { db = conv_desc(p, ws, 0, i1); conv_load(db, vb, gb, F.lane); }
            conv_finish(da, va, ga, scr, F.lane); if (i1 >= n) break;
            const int i2 = i1 + F.NGW; if (i2 < n) { da = conv_desc(p, ws, 0, i2); conv_load(da, va, ga, F.lane); }
            conv_finish(db, vb, gb, scr, F.lane); if (i2 >= n) break; it = i2; } } }
    const int gt = F.gw * 64 + F.lane, NGT = F.NGW * 64;
    { GAS bf16* XB = (GAS bf16*)(ws + WS_XB); GAS float* RSB = (GAS float*)(ws + WS_RS) + MROWS;
      for (int r = F.gw; r < MROWS; r += F.NGW) { const float* src = (r < MP) ? p.in(I_XP) + (size_t)r * DM : p.in(I_XS) + (size_t)(r - MP) * DM;
          const GAS f32x4* xr = (const GAS f32x4*)src + F.lane; f32x4 v[8]; float s = 0.f;
#pragma unroll
          for (int j = 0; j < 8; ++j) { v[j] = xr[64 * j]; s += (v[j].x * v[j].x + v[j].y * v[j].y) + (v[j].z * v[j].z + v[j].w * v[j].w); }
          s = wave_sum(s, F.lane); if (F.lane == 0) RSB[r] = s;
          GAS u32x2* o8 = (GAS u32x2*)(XB + (size_t)r * DM) + F.lane;
#pragma unroll
          for (int j = 0; j < 8; ++j) o8[64 * j] = (u32x2){pg8::cvt_pk_bf16(v[j].x, v[j].y), pg8::cvt_pk_bf16(v[j].z, v[j].w)}; } }
    { float* LB = (float*)(ws + WS_LB); const float* lg = p.in(I_LBL);
      for (int c = gt; c < DM; c += NGT) { const float l0 = lg[c], l1 = lg[DM + c], m = fmaxf(l0, l1), e0 = expf(l0 - m), e1 = expf(l1 - m); LB[c] = 0.f; LB[DM + c] = e1 / (e0 + e1); } }
    { f32x2* TAB = (f32x2*)(ws + WS_ROPE);
      for (int idx = gt; idx < NPOS * 32; idx += NGT) { const int pi = idx >> 5, i = idx & 31; const double pos = (double)(pi < TP ? pi : 16384 + (pi - TP));
          double inv = 1.0; for (int k = 0; k < i; ++k) inv *= 0.7498942093324559;
          const double x = pos * inv, n = rint(x * 0.15915494309189535); double r = fma(-n, 6.283185307179586, x); r = fma(-n, 2.4492935982947064e-16, r);
          const double r2 = r * r; double s = 1.0, c = 1.0;
#pragma unroll
          for (int k = 14; k >= 1; --k) { s = 1.0 - r2 * (1.0 / (double)((2 * k) * (2 * k + 1))) * s; c = 1.0 - r2 * (1.0 / (double)((2 * k - 1) * (2 * k))) * c; }
          TAB[idx] = (f32x2){(float)c, (float)(r * s)}; } }
}

__device__ __forceinline__ f32x4 sample_row_reduce(const float* Xs, float* X, const float* SL, int rs, int ks_prev, int tid) {
    GAS f32x4* xp = (GAS f32x4*)(X + (size_t)(MP + rs) * DM) + tid; f32x4 v = *((const GAS f32x4*)(Xs + (size_t)rs * DM) + tid);
    if (ks_prev > 0) { const GAS f32x4* sp = (const GAS f32x4*)(SL + (size_t)rs * DM) + tid; f32x4 a0 = (f32x4){0.f, 0.f, 0.f, 0.f}, a1 = a0;
#pragma unroll 4
        for (int ks = 0; ks < ks_prev; ks += 2) { a0 += sp[(size_t)ks * 256 * (DM / 4)]; a1 += sp[(size_t)(ks + 1) * 256 * (DM / 4)]; }
        v += a0 + a1; *xp = v; }
    return v;
}
__device__ __forceinline__ void sample_reduce_publish(LAS unsigned char* lds, int ks_prev, const float* Xs, float* RSmine, float* RSzero, unsigned* cnt, int first_wg) {
    const Args p = get_args(); Frame F = make_frame(lds); float* X = p.out() + O_Y; const float* SL = (const float*)(p.ws() + WS_SLAB); GAS bf16* XB = (GAS bf16*)(p.ws() + WS_XB);
    for (int i = blockIdx.x * NTHREADS + F.tid; i < MP; i += F.G * NTHREADS) ((GAS float*)RSzero)[i] = 0.f;
    LAS float* red = (LAS float*)F.lds;
    for (int rs = (int)blockIdx.x - first_wg; rs >= 0 && rs < MS; rs += F.G - first_wg) {
        const int tid = F.tid; f32x4 v = *((const GAS f32x4*)(Xs + (size_t)rs * DM) + tid);
        { const GAS f32x4* sp = (const GAS f32x4*)(SL + (size_t)rs * DM) + tid; f32x4 t[22];
#pragma unroll
          for (int ks = 0; ks < 22; ++ks) t[ks] = (ks < ks_prev) ? sp[(size_t)ks * 256 * (DM / 4)] : (f32x4){0.f, 0.f, 0.f, 0.f};
#pragma unroll
          for (int ks = 0; ks < 22; ++ks) v += t[ks]; }
        GAS unsigned long long* xo = (GAS unsigned long long*)(X + (size_t)(MP + rs) * DM) + 2 * tid;
        __hip_atomic_store(xo, ((unsigned long long)__float_as_uint(v.y) << 32) | __float_as_uint(v.x), __ATOMIC_RELAXED, __HIP_MEMORY_SCOPE_AGENT);
        __hip_atomic_store(xo + 1, ((unsigned long long)__float_as_uint(v.w) << 32) | __float_as_uint(v.z), __ATOMIC_RELAXED, __HIP_MEMORY_SCOPE_AGENT);
        __hip_atomic_store((GAS unsigned long long*)(XB + (size_t)(MP + rs) * DM) + tid, ((unsigned long long)pg8::cvt_pk_bf16(v.z, v.w) << 32) | pg8::cvt_pk_bf16(v.x, v.y), __ATOMIC_RELAXED, __HIP_MEMORY_SCOPE_AGENT);
        const float s = wave_sum((v.x * v.x + v.y * v.y) + (v.z * v.z + v.w * v.w), F.lane);
        __syncthreads(); if (F.lane == 0) red[F.wave] = s; __syncthreads();
        if (tid == 0) { float tot = 0.f;
#pragma unroll
            for (int w = 0; w < NWAVES; ++w) tot += red[w];
            __hip_atomic_store((GAS unsigned*)(RSmine + MP + rs), __float_as_uint(tot), __ATOMIC_RELAXED, __HIP_MEMORY_SCOPE_AGENT); }
        asm volatile("s_waitcnt vmcnt(0)" ::: "memory"); __syncthreads();
        if (tid == 0) __hip_atomic_fetch_add(cnt, 1u, __ATOMIC_RELAXED, __HIP_MEMORY_SCOPE_AGENT);
    }
    __syncthreads();
}
__device__ __forceinline__ void phase_fix_sample(LAS unsigned char* lds, int ks_prev) {
    const Args p = get_args(); Frame F = make_frame(lds); float* X = p.out() + O_Y; const float* SL = (const float*)(p.ws() + WS_SLAB);
    for (int rs = blockIdx.x; rs < MS; rs += F.G) (void)sample_row_reduce(X + (size_t)MP * DM, X, SL, rs, ks_prev, F.tid);
}

struct GsIn { float S[32]; float st[8]; };
__device__ __forceinline__ void gs_issue(GsIn& x, const Args& p, unsigned char* ws, int l, int s, int tid) {
    const bf16* Q = (const bf16*)(ws + WS_Q); const bf16* V = (const bf16*)(ws + WS_V); const bf16* GT = (const bf16*)(ws + WS_GT); const float* LF = (const float*)(ws + WS_LF);
    const int b = s >> 4, h = s & 15, lane = tid & 63, dg = tid >> 6; const float* sin_ = p.in(I_ST) + ((size_t)(l * NBS + b) * NH + h) * DK * DK;
#pragma unroll
    for (int i = 0; i < 16; ++i) { const f32x2 v2 = *(const GAS f32x2*)(sin_ + (size_t)(dg * 16 + i) * DK + 2 * lane); x.S[2 * i] = v2.x; x.S[2 * i + 1] = v2.y; }
#pragma unroll
    for (int k = 0; k < 2; ++k) { const int e = tid + k * NTHREADS, t = e >> 7, c = e & 127; const size_t gi = (size_t)(MP + b * TS + t) * DM + h * DK + c;
        x.st[4 * k] = ((const GAS float*)LF)[gi]; x.st[4 * k + 1] = bf2f(((const GAS bf16*)Q)[gi]); x.st[4 * k + 2] = bf2f(((const GAS bf16*)V)[gi]); x.st[4 * k + 3] = bf2f(((const GAS bf16*)GT)[gi]); }
}
__device__ __forceinline__ void phase_gla_sample(LAS unsigned char* lds, int l) {
    static_assert(TS == 8 && NWAVES == 8 && DK == 128, "sample GLA mapping");
    const Args p = get_args(); Frame F = make_frame(lds); unsigned char* ws = p.ws(); float* const pout = p.out();
    LAS float* sf = (LAS float*)F.lds; LAS float* sk = sf + 1024; LAS float* sq = sf + 2048; LAS float* sv = sf + 3072; LAS float* sg = sf + 4096; LAS float* red = sf + 5120;
    bf16* H = (bf16*)(ws + WS_H); const float* gon = p.in(I_ONORM) + l * DK;
    const int tid = F.tid, lane = F.lane, dg = F.wave;
    int s = blockIdx.x; if (s >= NBS * NH) return;
    GsIn cur, nxt; gs_issue(cur, p, ws, l, s, tid);
    for (;;) {
        const int b = s >> 4, h = s & 15, sn = s + F.G; const bool more = sn < NBS * NH;
        __syncthreads();
#pragma unroll
        for (int k = 0; k < 2; ++k) { const int e = tid + k * NTHREADS; const float f = expf(cur.st[4 * k]); sf[e] = f; sk[e] = 1.0f - f; sq[e] = cur.st[4 * k + 1]; sv[e] = cur.st[4 * k + 2]; sg[e] = cur.st[4 * k + 3]; }
        if (more) gs_issue(nxt, p, ws, l, sn, tid);
        LDS_WAIT();
        __syncthreads();
#pragma unroll 2
        for (int t = 0; t < TS; ++t) { const f32x2 vt = *(const LAS f32x2*)(sv + t * 128 + 2 * lane); float op0 = 0.f, op1 = 0.f;
#pragma unroll
            for (int i4 = 0; i4 < 4; ++i4) { const f32x4 f4 = *(const LAS f32x4*)(sf + t * 128 + dg * 16 + i4 * 4), k4 = *(const LAS f32x4*)(sk + t * 128 + dg * 16 + i4 * 4), q4 = *(const LAS f32x4*)(sq + t * 128 + dg * 16 + i4 * 4);
#pragma unroll
                for (int e = 0; e < 4; ++e) { const int i = i4 * 4 + e; cur.S[2 * i] = f4[e] * cur.S[2 * i] + k4[e] * vt.x; cur.S[2 * i + 1] = f4[e] * cur.S[2 * i + 1] + k4[e] * vt.y; op0 += cur.S[2 * i] * q4[e]; op1 += cur.S[2 * i + 1] * q4[e]; } }
            *(LAS f32x2*)(red + (t * 8 + dg) * 128 + 2 * lane) = (f32x2){op0, op1}; }
        float* sout = pout + O_STS + ((size_t)(l * NBS + b) * NH + h) * DK * DK;
#pragma unroll
        for (int i = 0; i < 16; ++i) *(GAS f32x2*)(sout + (size_t)(dg * 16 + i) * DK + 2 * lane) = (f32x2){cur.S[2 * i], cur.S[2 * i + 1]};
        LDS_WAIT();
        __syncthreads();
        { const int t = F.wave, c0 = lane, c1 = lane + 64; float o0 = 0.f, o1 = 0.f;
#pragma unroll
            for (int d = 0; d < 8; ++d) { o0 += red[(t * 8 + d) * 128 + c0]; o1 += red[(t * 8 + d) * 128 + c1]; }
            const float rstd = 1.0f / sqrtf(wave_sum(o0 * o0 + o1 * o1, lane) * (1.0f / DK) + RMS_EPS);
            const float y0 = o0 * rstd * gon[c0] * sg[t * 128 + c0], y1 = o1 * rstd * gon[c1] * sg[t * 128 + c1];
            bf16* hp = H + (size_t)(MP + b * TS + t) * DM + h * DK;
            hp[c0] = (bf16)(pg8::cvt_pk_bf16(y0, 0.f) & 0xffffu); hp[c1] = (bf16)(pg8::cvt_pk_bf16(y1, 0.f) & 0xffffu); }
        if (!more) break;
        s = sn;
#pragma unroll
        for (int i = 0; i < 32; ++i) cur.S[i] = nxt.S[i];
#pragma unroll
        for (int i = 0; i < 8; ++i) cur.st[i] = nxt.st[i];
    }
}

__device__ __forceinline__ void phase_post(LAS unsigned char* lds, int j) {
    const Args p = get_args(); Frame F = make_frame(lds); unsigned char* ws = p.ws(); float* const pout = p.out(); const bf16* RAW = (const bf16*)(ws + WS_RAW); float* QF = (float*)(ws + WS_QF); float* KF = (float*)(ws + WS_KF); float* VF = (float*)(ws + WS_VF); const float* SLB = (const float*)(ws + WS_SLAB);
    GAS unsigned char* QC = (GAS unsigned char*)(ws + WS_QC); GAS unsigned char* KC = (GAS unsigned char*)(ws + WS_KC); GAS unsigned char* VC = (GAS unsigned char*)(ws + WS_VC);
    const int ld = (j == 0) ? 3072 : 2048, qoff = (j == 0) ? 1024 : 0; const float qn = p.in(I_QNORM)[j * HD + F.lane], kn = p.in(I_KNORM)[F.lane];
    const f32x2* TAB = (const f32x2*)(ws + WS_ROPE); const int lane = F.lane;
    { const int rr = lane >> 3, db = lane & 7; const int NHV = (j == 0) ? NQH + NKV : NQH;
      f32x4 qn4[2], kn4[2];
#pragma unroll
      for (int e = 0; e < 2; ++e) { qn4[e] = *(const f32x4*)(p.in(I_QNORM) + j * HD + 8 * db + 4 * e); kn4[e] = *(const f32x4*)(p.in(I_KNORM) + 8 * db + 4 * e); }
      for (int it4 = F.gw; it4 < (MP / 8) * NHV / 4; it4 += F.NGW) {
        const int item0 = it4 * 4, rg = item0 / NHV, hv0 = item0 - rg * NHV; const bool isK = hv0 >= NQH; const int hh0 = isK ? hv0 - NQH : hv0; const int r = rg * 8 + rr, t = r & (TP - 1), b = r >> 12;
        const bf16* src = RAW + (size_t)r * ld + (isK ? 0 : qoff) + hh0 * HD + 8 * db; f32x4 x0[4], x1[4]; u32x4 xr[4];
#pragma unroll
        for (int u = 0; u < 4; ++u) xr[u] = *(const GAS u32x4*)(src + u * HD);
#pragma unroll
        for (int u = 0; u < 4; ++u) { x0[u] = (f32x4){__uint_as_float(xr[u].x << 16), __uint_as_float(xr[u].x & 0xffff0000u), __uint_as_float(xr[u].y << 16), __uint_as_float(xr[u].y & 0xffff0000u)};
            x1[u] = (f32x4){__uint_as_float(xr[u].z << 16), __uint_as_float(xr[u].z & 0xffff0000u), __uint_as_float(xr[u].w << 16), __uint_as_float(xr[u].w & 0xffff0000u)}; }
        const f32x4* tb = (const f32x4*)(TAB + t * 32 + 8 * (db & 3)); f32x4 c2[4];
#pragma unroll
        for (int e2 = 0; e2 < 4; ++e2) c2[e2] = tb[e2];
        const f32x4 g0 = isK ? kn4[0] : qn4[0], g1 = isK ? kn4[1] : qn4[1];
#pragma unroll
        for (int u = 0; u < 4; ++u) { const int hh = hh0 + u;
            float ss = (x0[u].x * x0[u].x + x0[u].y * x0[u].y) + (x0[u].z * x0[u].z + x0[u].w * x0[u].w) + (x1[u].x * x1[u].x + x1[u].y * x1[u].y) + (x1[u].z * x1[u].z + x1[u].w * x1[u].w);
            ss += shx(ss, 1, lane); ss += shx(ss, 2, lane); ss += shx(ss, 4, lane);
            const float rstd = 1.0f / sqrtf(ss * (1.0f / HD) + RMS_EPS);
            float y[8] = {x0[u].x * rstd * g0.x, x0[u].y * rstd * g0.y, x0[u].z * rstd * g0.z, x0[u].w * rstd * g0.w, x1[u].x * rstd * g1.x, x1[u].y * rstd * g1.y, x1[u].z * rstd * g1.z, x1[u].w * rstd * g1.w};
            float o[8];
#pragma unroll
            for (int e2 = 0; e2 < 4; ++e2) { const float p0 = shx(y[2 * e2], 4, lane), p1 = shx(y[2 * e2 + 1], 4, lane);
                o[2 * e2] = (db < 4) ? (y[2 * e2] * c2[e2].x - p0 * c2[e2].y) : (y[2 * e2] * c2[e2].x + p0 * c2[e2].y); o[2 * e2 + 1] = (db < 4) ? (y[2 * e2 + 1] * c2[e2].z - p1 * c2[e2].w) : (y[2 * e2 + 1] * c2[e2].z + p1 * c2[e2].w); }
            const u32x4 w = (u32x4){pk_bf16(o[0], o[1]), pk_bf16(o[2], o[3]), pk_bf16(o[4], o[5]), pk_bf16(o[6], o[7])};
            if (!isK) *(GAS u32x4*)(QC + ((size_t)(((r >> 5) * 32 + hh) * 4 + (db >> 1))) * 1024 + ((db & 1) * 32 + (r & 31)) * 16) = w;
            else { *(GAS u32x4*)(KC + ((size_t)((b * NKV + hh) * (TP / 32) + (t >> 5)) * 4 + (db >> 1)) * 1024 + ((db & 1) * 32 + (t & 31)) * 16) = w;
                if (t >= TP - WIN) { float* kwo = pout + O_KWP + ((size_t)b * WIN + (t - (TP - WIN))) * KVW + hh * HD + 8 * db; *(f32x4*)kwo = (f32x4){o[0], o[1], o[2], o[3]}; *(f32x4*)(kwo + 4) = (f32x4){o[4], o[5], o[6], o[7]}; } } }
      } }
    if (j == 0) {
      for (int rg = F.gw; rg < MP / 4; rg += F.NGW) {
        const int r0 = rg * 4, t0 = r0 & (TP - 1), b = r0 >> 12; float vv[NKV][4];
#pragma unroll
        for (int hh = 0; hh < NKV; ++hh)
#pragma unroll
            for (int e = 0; e < 4; ++e) vv[hh][e] = bf2f(((const GAS bf16*)RAW)[(size_t)(r0 + e) * ld + KVW + hh * HD + lane]);
        const int kk = t0 & 31, sp = kk >> 4, k16 = kk & 15, hV = (k16 & 7) >> 2, jV = 4 * (k16 >> 3), dt = lane >> 5;
#pragma unroll
        for (int hh = 0; hh < NKV; ++hh) {
            *(GAS u32x2*)(VC + ((size_t)((b * NKV + hh) * (TP / 32) + (t0 >> 5)) * 4 + dt * 2 + sp) * 1024 + (hV * 32 + (lane & 31)) * 16 + jV * 2) = (u32x2){pk_bf16(vv[hh][0], vv[hh][1]), pk_bf16(vv[hh][2], vv[hh][3])};
            if (t0 >= TP - WIN) {
#pragma unroll
                for (int e = 0; e < 4; ++e) pout[O_VWP + ((size_t)b * WIN + (t0 + e - (TP - WIN))) * KVW + hh * HD + lane] = vv[hh][e]; } }
      } }
    const int NV = (j == 0) ? 48 : 32;
    for (int item0 = F.gw; item0 < MS * NV; item0 += 2 * F.NGW) {
        float xs[2]; int rs_[2], hv_[2]; bool ok[2];
#pragma unroll
        for (int u = 0; u < 2; ++u) { const int item = item0 + u * F.NGW; ok[u] = item < MS * NV; const int it = ok[u] ? item : item0; rs_[u] = it / NV; hv_[u] = it - rs_[u] * NV;
            const int kind = (j == 0) ? (hv_[u] < 8 ? 1 : (hv_[u] < 16 ? 2 : 0)) : 0; const int hh = (j == 0) ? (kind == 1 ? hv_[u] : (kind == 2 ? hv_[u] - 8 : hv_[u] - 16)) : hv_[u];
            const float* sp = SLB + (size_t)rs_[u] * ld + (kind == 0 ? qoff : (kind == 2 ? KVW : 0)) + hh * HD + lane; float x = 0.f;
#pragma unroll
            for (int ks = 0; ks < 8; ++ks) x += sp[(size_t)ks * 256 * ld];
            xs[u] = x; }
#pragma unroll
        for (int u = 0; u < 2; ++u) if (ok[u]) { const int rs = rs_[u], hv = hv_[u], r = MP + rs, s_ = rs & (TS - 1), b = rs >> 3; const float x = xs[u];
            const int kind = (j == 0) ? (hv < 8 ? 1 : (hv < 16 ? 2 : 0)) : 0;
            const int hh = (j == 0) ? (kind == 1 ? hv : (kind == 2 ? hv - 8 : hv - 16)) : hv;
            const f32x2 cs = TAB[(TP + s_) * 32 + (lane & 31)];
            const float y = x * (1.0f / sqrtf(wave_sum(x * x, lane) * (1.0f / HD) + RMS_EPS)) * (kind == 0 ? qn : kn); const float pr = shx(y, 32, lane);
            const float o = (lane < 32) ? (y * cs.x - pr * cs.y) : (y * cs.x + pr * cs.y);
            if (kind == 0) QF[(size_t)r * DM + hh * HD + lane] = o;
            else if (kind == 1) { KF[(size_t)r * KVW + hh * HD + lane] = o; pout[O_KWS + ((size_t)b * WIN + (WIN - TS + s_)) * KVW + hh * HD + lane] = o; }
            else { VF[(size_t)r * KVW + hh * HD + lane] = x; pout[O_VWS + ((size_t)b * WIN + (WIN - TS + s_)) * KVW + hh * HD + lane] = x; } }
    }
    if (j == 0) {
        const int gt = F.gw * 64 + lane, NGT = F.NGW * 64; const float* ck = p.in(I_CK); const float* cv = p.in(I_CV); constexpr int PER = (WIN - TS) * KVW;
        for (int i = gt; i < NBS * PER; i += NGT) { const int b = i / PER, rem = i - b * PER; const size_t d = (size_t)b * WIN * KVW + rem, s = d + (size_t)TS * KVW; pout[O_KWS + d] = ck[s]; pout[O_VWS + d] = cv[s]; }
    }
}

__device__ __forceinline__ void phase_attn_simple(LAS unsigned char* lds, int j) {
    static_assert(TS == NWAVES && HD == 64 && WIN == 128, "sample attention mapping");
    const Args p = get_args(); Frame F = make_frame(lds); unsigned char* ws = p.ws(); const float* QF = (const float*)(ws + WS_QF); const float* KF = (const float*)(ws + WS_KF); const float* VF = (const float*)(ws + WS_VF); bf16* H = (bf16*)(ws + WS_H);
    LAS float* sq = (LAS float*)F.lds + F.wave * 768; LAS float* sp = sq + 256; LAS float* KS = (LAS float*)(F.lds + 24576); LAS float* VS = (LAS float*)(F.lds + 61440);
    constexpr int NROW = WIN + TS - 1, KST = 68;
    const float* sinks = p.in(I_SINKS) + j * NQH; const float* ck = p.in(I_CK); const float* cv = p.in(I_CV); const int lane = F.lane;
    for (int u = blockIdx.x; u < NBS * NKV; u += F.G) {
        const int b = u >> 3, kvh = u & 7, t = F.wave, r = MP + b * TS + t;
        __syncthreads();
        f32x4 kx[5], vx[5];
#pragma unroll
        for (int i = 0; i < 5; ++i) { const int idx = F.tid + i * NTHREADS, row = idx >> 4, pc = idx & 15, a = row + 1;
            if (row < NROW) { const size_t off = (a < WIN) ? ((size_t)(b * WIN + a) * NKV + kvh) * HD : (size_t)(MP + b * TS + (a - WIN)) * KVW + kvh * HD;
                kx[i] = *(const GAS f32x4*)(((a < WIN) ? ck : KF) + off + 4 * pc); vx[i] = *(const GAS f32x4*)(((a < WIN) ? cv : VF) + off + 4 * pc); } }
#pragma unroll
        for (int g = 0; g < 4; ++g) sq[g * 64 + lane] = QF[(size_t)r * DM + (kvh * 4 + g) * HD + lane];
#pragma unroll
        for (int i = 0; i < 5; ++i) { const int idx = F.tid + i * NTHREADS, row = idx >> 4, pc = idx & 15;
            if (row < NROW) { *(LAS f32x4*)(KS + row * KST + 4 * pc) = kx[i]; *(LAS f32x4*)(VS + row * HD + 4 * pc) = vx[i]; } }
        LDS_WAIT();
        __syncthreads();
        const int kq = lane & 31, dh = lane >> 5;
        float sc[4][4];
#pragma unroll
        for (int jj = 0; jj < 4; ++jj)
#pragma unroll
            for (int g = 0; g < 4; ++g) sc[jj][g] = 0.f;
        const LAS float* kp = KS + (t + kq) * KST + 32 * dh; const LAS float* qp = sq + 32 * dh;
#pragma unroll 2
        for (int d4 = 0; d4 < 8; ++d4) { f32x4 ka[4];
#pragma unroll
            for (int jj = 0; jj < 4; ++jj) ka[jj] = *(const LAS f32x4*)(kp + jj * 32 * KST + 4 * d4);
#pragma unroll
            for (int g = 0; g < 4; ++g) { const f32x4 q4 = *(const LAS f32x4*)(qp + g * 64 + 4 * d4);
#pragma unroll
                for (int jj = 0; jj < 4; ++jj) sc[jj][g] += (q4.x * ka[jj].x + q4.y * ka[jj].y) + (q4.z * ka[jj].z + q4.w * ka[jj].w); } }
#pragma unroll
        for (int g = 0; g < 4; ++g) { const float sk_ = sinks[kvh * 4 + g]; float sv_[4], m = sk_;
#pragma unroll
            for (int jj = 0; jj < 4; ++jj) { sv_[jj] = (sc[jj][g] + shx(sc[jj][g], 32, lane)) * 0.125f; m = fmaxf(m, sv_[jj]); }
            m = wave_max(m, lane); float ps = 0.f, pj[4];
#pragma unroll
            for (int jj = 0; jj < 4; ++jj) { pj[jj] = expf(sv_[jj] - m); ps += pj[jj]; }
            const float inv = 1.0f / (0.5f * wave_sum(ps, lane) + expf(sk_ - m));
#pragma unroll
            for (int jj = 0; jj < 4; ++jj) sp[g * 128 + kq + 32 * jj] = pj[jj] * inv; }
        LDS_WAIT();
        const int c2 = lane & 31, sh = lane >> 5;
        float a0[4] = {0.f, 0.f, 0.f, 0.f}, a1[4] = {0.f, 0.f, 0.f, 0.f}; const LAS float* vb = VS + (t + 64 * sh) * HD + 2 * c2; const LAS float* pb = sp + 64 * sh;
#pragma unroll 2
        for (int s4 = 0; s4 < 16; ++s4) { f32x2 v[4];
#pragma unroll
            for (int jj = 0; jj < 4; ++jj) v[jj] = *(const LAS f32x2*)(vb + (4 * s4 + jj) * HD);
#pragma unroll
            for (int g = 0; g < 4; ++g) { const f32x4 p4 = *(const LAS f32x4*)(pb + g * 128 + 4 * s4);
                a0[g] += (p4.x * v[0].x + p4.y * v[1].x) + (p4.z * v[2].x + p4.w * v[3].x); a1[g] += (p4.x * v[0].y + p4.y * v[1].y) + (p4.z * v[2].y + p4.w * v[3].y); } }
#pragma unroll
        for (int g = 0; g < 4; ++g) { a0[g] += shx(a0[g], 32, lane); a1[g] += shx(a1[g], 32, lane);
            if (sh == 0) *(GAS unsigned*)(H + (size_t)r * DM + (kvh * 4 + g) * HD + 2 * c2) = pg8::cvt_pk_bf16(a0[g], a1[g]); }
        LDS_WAIT();
    }
}


constexpr int OPS_QT = 0, OPS_KT = 8192, OPS_VF = 16384, OPS_AI = 24576, OPS_DEC = 26624, OPS_ITEM = 27648;
constexpr int NSEG = 8, SEG_STEPS = 16, NSTEPS = TP / 32;

__device__ __forceinline__ void phase_gla_pre(LAS unsigned char* lds, int l) {
    (void)l; const Args p = get_args(); Frame F = make_frame(lds); unsigned char* ws = p.ws();
    const GAS bf16* Q = (const GAS bf16*)(ws + WS_Q); const GAS bf16* V = (const GAS bf16*)(ws + WS_V); const GAS float* LF = (const GAS float*)(ws + WS_LF);
    GAS unsigned char* OPS = (GAS unsigned char*)(ws + WS_OPS);
    const int lane = F.lane; LAS unsigned char* QP = F.lds + F.wave * 17408; LAS unsigned char* KP = QP + 8704;
    const int pq = lane >> 4, dl = 2 * (lane & 15), qq = (dl < 16) ? (dl >> 2) : ((dl - 16) >> 2), jq = (dl < 16) ? (dl & 3) : (4 + ((dl - 16) & 3));
    const int c0 = 2 * lane, ti = c0 >> 4, tm = c0 & 15;
    for (int k = 0; k < ((NBP * NH * NSEG - 1 - (int)blockIdx.x) / F.G + 1) * 2; ++k) {
        const int u = blockIdx.x + (k >> 1) * F.G, it = (u >> 3) * NSTEPS + (u & 7) * SEG_STEPS + 2 * F.wave + (k & 1);
        const int s = it & (NSTEPS - 1), bh = it >> 7, b = bh >> 4, h = bh & 15; const size_t row0 = (size_t)b * TP + 32 * s; const int col = h * DK + c0;
        GAS unsigned char* ops = OPS + (size_t)it * OPS_ITEM;
        float g0[32], g1[32];
#pragma unroll
        for (int t = 0; t < 32; ++t) { const f32x2 x = *(const GAS f32x2*)(LF + (row0 + t) * DM + col); g0[t] = x.x; g1[t] = x.y; }
#pragma unroll
        for (int t = 1; t < 32; ++t) { g0[t] += g0[t - 1]; g1[t] += g1[t - 1]; }
        const float gl0 = g0[31], gl1 = g1[31], gm0 = g0[15], gm1 = g1[15];
        *(GAS f32x2*)(ops + OPS_DEC + lane * 8) = (f32x2){__expf(gl0), __expf(gl1)};
        unsigned qnx[8], vnx[8];
#pragma unroll
        for (int jj = 0; jj < 8; ++jj) { const size_t gi = (row0 + jj) * DM + col; qnx[jj] = *(const GAS unsigned*)(Q + gi); vnx[jj] = *(const GAS unsigned*)(V + gi); }
#pragma unroll
        for (int g = 0; g < 4; ++g) {
            unsigned qv[8], vv[8];
#pragma unroll
            for (int jj = 0; jj < 8; ++jj) { qv[jj] = qnx[jj]; vv[jj] = vnx[jj]; }
            if (g < 3) {
#pragma unroll
                for (int jj = 0; jj < 8; ++jj) { const size_t gi = (row0 + 8 * (g + 1) + jj) * DM + col; qnx[jj] = *(const GAS unsigned*)(Q + gi); vnx[jj] = *(const GAS unsigned*)(V + gi); } }
            float kh0[8], kh1[8];
#pragma unroll
            for (int jj = 0; jj < 8; ++jj) { const int t = 8 * g + jj; const float q0 = __uint_as_float(qv[jj] << 16), q1 = __uint_as_float(qv[jj] & 0xffff0000u);
                const float k0 = 1.0f - __expf(t ? g0[t] - g0[t - 1] : g0[0]), k1 = 1.0f - __expf(t ? g1[t] - g1[t - 1] : g1[0]);
                *(GAS unsigned*)(ops + OPS_QT + ((((t >> 4) * 4 + pq) * 64 + (qq * 16 + (t & 15))) * 16) + jq * 2) = pk_bf16(q0 * __expf(g0[t]), q1 * __expf(g1[t]));
                *(LAS unsigned*)(QP + t * 272 + lane * 4) = pk_bf16(q0 * __expf(g0[t] - gm0), q1 * __expf(g1[t] - gm1));
                *(LAS unsigned*)(KP + t * 272 + lane * 4) = pk_bf16(k0 * __expf(gm0 - g0[t]), k1 * __expf(gm1 - g1[t]));
                kh0[jj] = k0 * __expf(gl0 - g0[t]); kh1[jj] = k1 * __expf(gl1 - g1[t]); }
            u32x4 w0, w1, x0, x1;
            w0.x = pk_bf16(kh0[0], kh0[1]); w0.y = pk_bf16(kh0[2], kh0[3]); w0.z = pk_bf16(kh0[4], kh0[5]); w0.w = pk_bf16(kh0[6], kh0[7]);
            w1.x = pk_bf16(kh1[0], kh1[1]); w1.y = pk_bf16(kh1[2], kh1[3]); w1.z = pk_bf16(kh1[4], kh1[5]); w1.w = pk_bf16(kh1[6], kh1[7]);
            x0.x = (vv[0] & 0xffffu) | (vv[1] << 16); x0.y = (vv[2] & 0xffffu) | (vv[3] << 16); x0.z = (vv[4] & 0xffffu) | (vv[5] << 16); x0.w = (vv[6] & 0xffffu) | (vv[7] << 16);
            x1.x = (vv[0] >> 16) | (vv[1] & 0xffff0000u); x1.y = (vv[2] >> 16) | (vv[3] & 0xffff0000u); x1.z = (vv[4] >> 16) | (vv[5] & 0xffff0000u); x1.w = (vv[6] >> 16) | (vv[7] & 0xffff0000u);
            const int off = ti * 1024 + (g * 16 + tm) * 16;
            *(GAS u32x4*)(ops + OPS_KT + off) = w0; *(GAS u32x4*)(ops + OPS_KT + off + 16) = w1;
            *(GAS u32x4*)(ops + OPS_VF + off) = x0; *(GAS u32x4*)(ops + OPS_VF + off + 16) = x1;
        }
        LDS_WAIT();
        f32x16 acc;
#pragma unroll
        for (int r = 0; r < 16; ++r) acc[r] = 0.f;
#pragma unroll
        for (int ks = 0; ks < 8; ++ks) { const int o = (lane & 31) * 272 + (16 * ks + 8 * (lane >> 5)) * 2;
            const bf16x8 a = *(const LAS bf16x8*)(QP + o), bb = *(const LAS bf16x8*)(KP + o); acc = __builtin_amdgcn_mfma_f32_32x32x16_bf16(a, bb, acc, 0, 0, 0); }
        { const int j = lane & 31;
#pragma unroll
          for (int r = 0; r < 16; ++r) { const int t = (r & 3) + 8 * (r >> 2) + 4 * (lane >> 5); const float val = (j <= t) ? acc[r] : 0.f;
              *(GAS bf16*)(ops + OPS_AI + (t >> 4) * 1024 + ((j >> 3) * 16 + (t & 15)) * 16 + (j & 7) * 2) = (bf16)(pk_bf16(val, 0.f) & 0xffffu); } }
        LDS_WAIT();
    }
}

template <bool OUT> __device__ __forceinline__ void gla_seq(LAS unsigned char* lds, int l) {
    const Args p = get_args(); Frame F = make_frame(lds); unsigned char* ws = p.ws();
    constexpr int NPW = OUT ? 5 : 3, NCH = OUT ? 35 : 17, SLOT = NPW * 8 * 1024;
    constexpr int L_QT = 0, L_KT = OUT ? 8192 : 0, L_VF = OUT ? 16384 : 8192, L_AI = 24576, L_DEC = OUT ? 26624 : 16384, L_GT = 27648;
    LAS unsigned char* ssb = F.lds + 3 * SLOT;
    const int lane0 = F.lane, w = F.wave;
    const GAS unsigned char* OPS = (const GAS unsigned char*)(ws + WS_OPS); const GAS bf16* GT = (const GAS bf16*)(ws + WS_GT);
    GAS float* SLOC = (GAS float*)(ws + WS_SLOC); GAS float* DSEG = (GAS float*)(ws + WS_DSEG); GAS bf16* H = (GAS bf16*)(ws + WS_H);
    for (int u = blockIdx.x; u < NBP * NH * NSEG; u += F.G) {
        const int seg = u & (NSEG - 1), bh = u >> 3, b = bh >> 4, h = bh & 15; const int item0 = bh * NSTEPS + seg * SEG_STEPS; const size_t row0 = (size_t)b * TP + seg * (SEG_STEPS * 32);
        f32x4 Sacc[8];
#pragma unroll
        for (int i = 0; i < 8; ++i) Sacc[i] = (f32x4){0.f, 0.f, 0.f, 0.f};
        f32x4 gon = (f32x4){0.f, 0.f, 0.f, 0.f}; f32x4 P[8];
        if constexpr (OUT) {
            gon = *(const GAS f32x4*)((const GAS float*)p.in(I_ONORM) + l * DK + 16 * w + 4 * (lane0 >> 4));
            if (seg > 0) { f32x4 da[8], sa[8], db[8], sb[8];
                auto ldseg = [&](int g, f32x4 (&d)[8], f32x4 (&sl)[8]) { const int ug = bh * NSEG + g;
#pragma unroll
                    for (int i = 0; i < 8; ++i) { d[i] = *(const GAS f32x4*)(DSEG + (size_t)ug * DK + 16 * i + 4 * (lane0 >> 4)); sl[i] = *(const GAS f32x4*)(SLOC + (((size_t)ug * 8 + w) * 8 + i) * 256 + lane0 * 4); } };
                for (int g = 0; g < seg; g += 2) { const bool two = g + 1 < seg;
                    ldseg(g, da, sa); ldseg(two ? g + 1 : g, db, sb);
#pragma unroll
                    for (int i = 0; i < 8; ++i) Sacc[i] = da[i] * Sacc[i] + sa[i];
                    if (two) {
#pragma unroll
                        for (int i = 0; i < 8; ++i) Sacc[i] = db[i] * Sacc[i] + sb[i]; } } }
        } else {
#pragma unroll
            for (int i = 0; i < 8; ++i) P[i] = (f32x4){1.f, 1.f, 1.f, 1.f};
        }
        int lane = lane0; asm volatile("" : "+v"(lane));
        const int n = lane & 15, q = lane >> 4;
        auto issue = [&](int s) { const int sc = s < SEG_STEPS ? s : SEG_STEPS - 1; const GAS unsigned char* ops = OPS + (size_t)(item0 + sc) * OPS_ITEM; LAS unsigned char* slot = F.lds + (s % 3) * SLOT;
#pragma unroll
            for (int k = 0; k < NPW; ++k) { int c = w + 8 * k; const int cl = c; if (c >= NCH) c = NCH - 1; const GAS unsigned char* src;
                if constexpr (OUT) { if (c < 27) src = ops + c * 1024 + lane * 16; else src = (const GAS unsigned char*)(GT + (row0 + 32 * sc + 4 * (c - 27) + (lane >> 4)) * DM + h * DK) + (lane & 15) * 16; }
                else { src = ops + (c < 16 ? OPS_KT + c * 1024 : OPS_DEC) + lane * 16; }
                __builtin_amdgcn_global_load_lds((const GAS unsigned*)src, (LAS unsigned*)(slot + cl * 1024), 16, 0, 0); } };
        issue(0); issue(1);
        f32x4 OT[2]; OT[0] = (f32x4){0.f, 0.f, 0.f, 0.f}; OT[1] = OT[0]; u32x2 gtr[2]; gtr[0] = (u32x2){0u, 0u}; gtr[1] = gtr[0];
        auto finalize = [&](int s) {
#pragma unroll
            for (int nt = 0; nt < 2; ++nt) { float tot = 0.f;
#pragma unroll
                for (int ww = 0; ww < 8; ++ww) tot += *(const LAS float*)(ssb + (((s & 1) * 8 + ww) * 32 + 16 * nt + n) * 4);
                const float rstd = 1.0f / sqrtf(tot * (1.0f / DK) + RMS_EPS);
                const float g0 = __uint_as_float(gtr[nt].x << 16), g1 = __uint_as_float(gtr[nt].x & 0xffff0000u), g2 = __uint_as_float(gtr[nt].y << 16), g3 = __uint_as_float(gtr[nt].y & 0xffff0000u);
                const u32x2 o = (u32x2){pk_bf16(OT[nt][0] * rstd * gon[0] * g0, OT[nt][1] * rstd * gon[1] * g1), pk_bf16(OT[nt][2] * rstd * gon[2] * g2, OT[nt][3] * rstd * gon[3] * g3)};
                *(GAS u32x2*)(H + (row0 + 32 * s + 16 * nt + n) * DM + h * DK + 16 * w + 4 * q) = o; } };
        for (int s = 0; s < SEG_STEPS; ++s) {
            if constexpr (OUT) asm volatile("s_waitcnt vmcnt(5)" ::: "memory"); else asm volatile("s_waitcnt vmcnt(3)" ::: "memory");
            __builtin_amdgcn_s_barrier(); asm volatile("" ::: "memory");
            if constexpr (OUT) { if (s >= 1) finalize(s - 1); }
            issue(s + 2);
            const LAS unsigned char* slot = F.lds + (s % 3) * SLOT;
            const bf16x8 vf = *(const LAS bf16x8*)(slot + L_VF + w * 1024 + lane * 16);
            if constexpr (OUT) {
                bf16x8 sf[4];
#pragma unroll
                for (int pp = 0; pp < 4; ++pp) { u32x4 t; t.x = pk_bf16(Sacc[2 * pp][0], Sacc[2 * pp][1]); t.y = pk_bf16(Sacc[2 * pp][2], Sacc[2 * pp][3]); t.z = pk_bf16(Sacc[2 * pp + 1][0], Sacc[2 * pp + 1][1]); t.w = pk_bf16(Sacc[2 * pp + 1][2], Sacc[2 * pp + 1][3]);
                    sf[pp] = __builtin_bit_cast(bf16x8, t); }
#pragma unroll
                for (int nt = 0; nt < 2; ++nt) { f32x4 o = (f32x4){0.f, 0.f, 0.f, 0.f};
#pragma unroll
                    for (int pp = 0; pp < 4; ++pp) { const bf16x8 qt = *(const LAS bf16x8*)(slot + L_QT + (nt * 4 + pp) * 1024 + lane * 16); o = __builtin_amdgcn_mfma_f32_16x16x32_bf16(sf[pp], qt, o, 0, 0, 0); }
                    const bf16x8 ai = *(const LAS bf16x8*)(slot + L_AI + nt * 1024 + lane * 16); o = __builtin_amdgcn_mfma_f32_16x16x32_bf16(vf, ai, o, 0, 0, 0);
                    OT[nt] = o; gtr[nt] = *(const LAS u32x2*)(slot + L_GT + (16 * nt + n) * 256 + (16 * w + 4 * q) * 2);
                    float ss = (o[0] * o[0] + o[1] * o[1]) + (o[2] * o[2] + o[3] * o[3]); ss += shx(ss, 16, lane); ss += shx(ss, 32, lane);
                    if (q == 0) *(LAS float*)(ssb + (((s & 1) * 8 + w) * 32 + 16 * nt + n) * 4) = ss; }
            }
#pragma unroll
            for (int i = 0; i < 8; ++i) { const f32x4 d = *(const LAS f32x4*)(slot + L_DEC + (16 * i + 4 * q) * 4); const bf16x8 kt = *(const LAS bf16x8*)(slot + L_KT + i * 1024 + lane * 16);
                if constexpr (!OUT) P[i] = P[i] * d;
                Sacc[i] = __builtin_amdgcn_mfma_f32_16x16x32_bf16(kt, vf, d * Sacc[i], 0, 0, 0); }
            LDS_WAIT();
        }
        asm volatile("s_waitcnt vmcnt(0)" ::: "memory");
        __builtin_amdgcn_s_barrier(); asm volatile("" ::: "memory");
        if constexpr (OUT) {
            finalize(SEG_STEPS - 1);
            if (seg == NSEG - 1) { GAS float* so = (GAS float*)p.out() + O_STP + ((size_t)(l * NBP + b) * NH + h) * DK * DK;
#pragma unroll
                for (int i = 0; i < 8; ++i)
#pragma unroll
                    for (int r = 0; r < 4; ++r) so[(size_t)(16 * i + 4 * q + r) * DK + 16 * w + n] = Sacc[i][r]; }
        } else {
#pragma unroll
            for (int i = 0; i < 8; ++i) { *(GAS f32x4*)(SLOC + (((size_t)u * 8 + w) * 8 + i) * 256 + lane * 4) = Sacc[i]; if (w == 0 && n == 0) *(GAS f32x4*)(DSEG + (size_t)u * DK + 16 * i + 4 * q) = P[i]; }
        }
        asm volatile("s_waitcnt vmcnt(0) lgkmcnt(0)" ::: "memory");
        __builtin_amdgcn_s_barrier(); asm volatile("" ::: "memory");

    }
}

__device__ __forceinline__ void phase_attn_prompt(LAS unsigned char* lds, int j) {
    const Args p = get_args(); Frame F = make_frame(lds); unsigned char* ws = p.ws();
    const GAS unsigned char* QC = (const GAS unsigned char*)(ws + WS_QC); const GAS unsigned char* KC = (const GAS unsigned char*)(ws + WS_KC); const GAS unsigned char* VC = (const GAS unsigned char*)(ws + WS_VC); GAS bf16* H = (GAS bf16*)(ws + WS_H);
    const int lane = F.lane, w = F.wave, g = w >> 1, rh = w & 1, ql = lane & 31, hl = lane >> 5;
    for (int u = blockIdx.x; u < NBP * NKV * (TP / 64); u += F.G) {
        const int qb = u & 63, kvh = (u >> 6) & 7, b = u >> 9, hq = kvh * 4 + g, qt = qb * 2 + rh;
        const float sink = p.in(I_SINKS)[j * NQH + hq];
        bf16x8 qf[4];
#pragma unroll
        for (int s = 0; s < 4; ++s) qf[s] = *(const GAS bf16x8*)(QC + ((size_t)((b * (TP / 32) + qt) * 32 + hq) * 4 + s) * 1024 + lane * 16);
        const GAS unsigned char* kbase = KC + (size_t)((b * NKV + kvh) * (TP / 32)) * 4096; const GAS unsigned char* vbase = VC + (size_t)((b * NKV + kvh) * (TP / 32)) * 4096;
        bf16x8 kf[3][4];
#pragma unroll
        for (int ti = 0; ti < 3; ++ti) { const int kt = qt - 4 + ti, ktc = kt < 0 ? 0 : kt;
#pragma unroll
            for (int s = 0; s < 4; ++s) kf[ti][s] = *(const GAS bf16x8*)(kbase + (size_t)(ktc * 4 + s) * 1024 + lane * 16); }
        f32x16 st[5];
#pragma unroll
        for (int ti = 0; ti < 5; ++ti) { const int kt = qt - 4 + ti; f32x16 acc;
#pragma unroll
            for (int r = 0; r < 16; ++r) acc[r] = 0.f;
#pragma unroll
            for (int s = 0; s < 4; ++s) acc = __builtin_amdgcn_mfma_f32_32x32x16_bf16(kf[ti % 3][s], qf[s], acc, 0, 0, 0);
            if (ti + 3 < 5) { const int k2 = qt - 1 + ti, k2c = k2 < 0 ? 0 : k2; asm volatile("" : "+v"(acc) :: "memory");
#pragma unroll
                for (int s = 0; s < 4; ++s) kf[ti % 3][s] = *(const GAS bf16x8*)(kbase + (size_t)(k2c * 4 + s) * 1024 + lane * 16); }
#pragma unroll
            for (int r = 0; r < 16; ++r) { const int krow = (r & 3) + 8 * (r >> 2) + 4 * hl; float x = acc[r] * 0.125f;
                if (ti == 0) x = (krow > ql) ? x : -1e30f;
                if (ti == 4) x = (krow <= ql) ? x : -1e30f;
                st[ti][r] = (kt >= 0) ? x : -1e30f; } }
        asm volatile("" : "+v"(st[4]) :: "memory");
        bf16x8 vfa[3][2][2];
#pragma unroll
        for (int ti = 0; ti < 3; ++ti) { const int kt = qt - 4 + ti, ktc = kt < 0 ? 0 : kt;
#pragma unroll
            for (int sp = 0; sp < 2; ++sp)
#pragma unroll
                for (int dt = 0; dt < 2; ++dt) vfa[ti][sp][dt] = *(const GAS bf16x8*)(vbase + (size_t)(ktc * 4 + dt * 2 + sp) * 1024 + lane * 16); }
        float mx = -1e30f;
#pragma unroll
        for (int ti = 0; ti < 5; ++ti)
#pragma unroll
            for (int r = 0; r < 16; ++r) mx = fmaxf(mx, st[ti][r]);
        mx = fmaxf(mx, shx(mx, 32, lane)); mx = fmaxf(mx, sink);
        float sum = 0.f;
#pragma unroll
        for (int ti = 0; ti < 5; ++ti)
#pragma unroll
            for (int r = 0; r < 16; ++r) { const float e = __expf(st[ti][r] - mx); st[ti][r] = e; sum += e; }
        sum += shx(sum, 32, lane);
        const float inv = 1.0f / (sum + __expf(sink - mx));
        f32x16 ot[2];
#pragma unroll
        for (int r = 0; r < 16; ++r) { ot[0][r] = 0.f; ot[1][r] = 0.f; }
#pragma unroll
        for (int ti = 0; ti < 5; ++ti) {
#pragma unroll
            for (int sp = 0; sp < 2; ++sp) { u32x4 t; t.x = pk_bf16(st[ti][8 * sp + 0], st[ti][8 * sp + 1]); t.y = pk_bf16(st[ti][8 * sp + 2], st[ti][8 * sp + 3]); t.z = pk_bf16(st[ti][8 * sp + 4], st[ti][8 * sp + 5]); t.w = pk_bf16(st[ti][8 * sp + 6], st[ti][8 * sp + 7]);
                const bf16x8 pf = __builtin_bit_cast(bf16x8, t);
#pragma unroll
                for (int dt = 0; dt < 2; ++dt) ot[dt] = __builtin_amdgcn_mfma_f32_32x32x16_bf16(vfa[ti % 3][sp][dt], pf, ot[dt], 0, 0, 0); }
            if (ti + 3 < 5) { const int k2 = qt - 1 + ti, k2c = k2 < 0 ? 0 : k2; asm volatile("" : "+v"(ot[0]), "+v"(ot[1]) :: "memory");
#pragma unroll
                for (int sp = 0; sp < 2; ++sp)
#pragma unroll
                    for (int dt = 0; dt < 2; ++dt) vfa[ti % 3][sp][dt] = *(const GAS bf16x8*)(vbase + (size_t)(k2c * 4 + dt * 2 + sp) * 1024 + lane * 16); } }
        GAS bf16* orow = H + ((size_t)b * TP + 32 * qt + ql) * DM + hq * HD + 4 * hl;
#pragma unroll
        for (int dt = 0; dt < 2; ++dt)
#pragma unroll
            for (int rq = 0; rq < 4; ++rq) *(GAS u32x2*)(orow + 32 * dt + 8 * rq) = (u32x2){pk_bf16(ot[dt][4 * rq] * inv, ot[dt][4 * rq + 1] * inv), pk_bf16(ot[dt][4 * rq + 2] * inv, ot[dt][4 * rq + 3] * inv)};
    }
}

constexpr int N_PHASES = 1 + 2 * 6 + 2 * 6 + 1;
#ifndef ONLY
#define ONLY 0
#endif
#ifndef MASK
#define MASK 0
#endif
#define SEL(k) ((ONLY == 0 && MASK == 0) || ONLY == (k) || ((MASK >> (k)) & 1))
__device__ __forceinline__ void gphase_hproj(LAS unsigned char* lds, int l) {
    const Args p = get_args(); unsigned char* ws = p.ws(); int tid = threadIdx.x; asm volatile("" : "+v"(tid));
    float* RSA = (float*)(ws + WS_RS); float* RSB = RSA + MROWS; unsigned* cnt = (unsigned*)(ws + WS_CTL) + CW_CNT + 64 * (2 * l);
    if (l > 0) sample_reduce_publish(lds, 22, p.out() + O_Y + (size_t)MP * DM, RSB, RSA, cnt, 32);
    else { for (int i = blockIdx.x * NTHREADS + tid; i < MP; i += (int)gridDim.x * NTHREADS) ((GAS float*)RSA)[i] = 0.f; }
    pg8::Gemm g{(const bf16*)(ws + WS_XB), (const bf16*)(ws + WS_WH) + (size_t)l * 8192 * 2048, MROWS, 8192, DM}; pg8::StaticOrder S; S.init(MROWS, 8192, DM, (int)gridDim.x, (int)blockIdx.x); S.cnt = cnt; S.need = (l > 0) ? (unsigned)MS : 0u; S.tmo = (unsigned*)(ws + WS_CTL) + CW_TMO2;
    pg8::EpiHproj E{ws, l};
    pg8::gemm_phase<pg8::EpiHproj, pg8::StaticOrder, true, true>(lds, g, S, E, tid);
}
__device__ __forceinline__ void gphase_qkv(LAS unsigned char* lds, int j) {
    const Args p = get_args(); unsigned char* ws = p.ws(); int tid = threadIdx.x; asm volatile("" : "+v"(tid));
    float* RSA = (float*)(ws + WS_RS); float* RSB = RSA + MROWS; unsigned* cnt = (unsigned*)(ws + WS_CTL) + CW_CNT + 64 * (2 * (j + 2));
    sample_reduce_publish(lds, 22, p.out() + O_Y + (size_t)MP * DM, RSB, RSA, cnt, j == 0 ? 128 : 64);
    const int N = (j == 0) ? 3072 : 2048; pg8::Gemm g{(const bf16*)(ws + WS_XB), (const bf16*)(ws + (j == 0 ? WS_WQKV0 : WS_WQ1)), MROWS, N, DM}; pg8::SplitOrder S; S.init(N, DM, 8, (int)gridDim.x, (int)blockIdx.x); S.cnt = cnt; S.need = (unsigned)MS; S.tmo = (unsigned*)(ws + WS_CTL) + CW_TMO2;
    pg8::EpiRaw E{(bf16*)(ws + WS_RAW), N, (float*)(ws + WS_SLAB), RSB};
    pg8::gemm_phase<pg8::EpiRaw, pg8::SplitOrder, true, true>(lds, g, S, E, tid);
}
__device__ __forceinline__ void gphase_wo(LAS unsigned char* lds, int l) {
    const Args p = get_args(); unsigned char* ws = p.ws(); int tid = threadIdx.x; asm volatile("" : "+v"(tid));
    const bf16* Bt = (l < 2) ? (const bf16*)(ws + WS_WOH) + (size_t)l * DM * DM : (const bf16*)(ws + WS_WOA) + (size_t)(l - 2) * DM * DM;
    pg8::Gemm g{(const bf16*)(ws + WS_H), Bt, MROWS, DM, DM}; pg8::SplitOrder S; S.init(DM, DM, 8, (int)gridDim.x, (int)blockIdx.x, 1); S.cnt = nullptr; S.need = 0u; S.tmo = nullptr; pg8::EpiResid E{(l == 0) ? p.in(I_XP) : nullptr, nullptr, DM, (float*)(ws + WS_SLAB), (bf16*)(ws + WS_XB), (bf16*)(ws + WS_XL), (float*)(ws + WS_RS)};
    pg8::gemm_phase<pg8::EpiResid, pg8::SplitOrder, true, true>(lds, g, S, E, tid);
}
__device__ __forceinline__ void gphase_ffn1(LAS unsigned char* lds, int l) {
    const Args p = get_args(); unsigned char* ws = p.ws(); int tid = threadIdx.x; asm volatile("" : "+v"(tid));
    float* RSA = (float*)(ws + WS_RS); float* RSB = RSA + MROWS; unsigned* cnt = (unsigned*)(ws + WS_CTL) + CW_CNT + 64 * (2 * l + 1);
    sample_reduce_publish(lds, 8, (l == 0) ? p.in(I_XS) : p.out() + O_Y + (size_t)MP * DM, RSA, RSB, cnt, 172);
    pg8::Gemm g{(const bf16*)(ws + WS_XB), (const bf16*)(ws + WS_WGU) + (size_t)l * 2 * DFF * DM, MROWS, 2 * DFF, DM}; pg8::StaticOrder S; S.init(MROWS, 2 * DFF, DM, (int)gridDim.x, (int)blockIdx.x); S.cnt = cnt; S.need = (unsigned)MS; S.tmo = (unsigned*)(ws + WS_CTL) + CW_TMO2; pg8::EpiFfn1 E{(bf16*)(ws + WS_ACT), DFF, RSA};
    pg8::gemm_phase<pg8::EpiFfn1, pg8::StaticOrder, true, true>(lds, g, S, E, tid);
}
__device__ __forceinline__ void gphase_ffn2(LAS unsigned char* lds, int l) {
    const Args p = get_args(); unsigned char* ws = p.ws(); int tid = threadIdx.x; asm volatile("" : "+v"(tid));
    pg8::Gemm g{(const bf16*)(ws + WS_ACT), (const bf16*)(ws + WS_WD) + (size_t)l * DM * DFF, MROWS, DM, DFF}; pg8::SplitOrder S; S.init(DM, DFF, 22, (int)gridDim.x, (int)blockIdx.x, 1); S.cnt = nullptr; S.need = 0u; S.tmo = nullptr; pg8::EpiResid E{nullptr, (l == 3) ? p.out() + O_Y : nullptr, DM, (float*)(ws + WS_SLAB), (bf16*)(ws + WS_XB), (bf16*)(ws + WS_XL), (float*)(ws + WS_RS) + MROWS};
    pg8::gemm_phase<pg8::EpiResid, pg8::SplitOrder, true, true>(lds, g, S, E, tid);
}
#ifndef V1_SPLIT
#define V1_SPLIT 0
#endif
#if V1_SPLIT
__global__ void __launch_bounds__(NTHREADS, 2) k_gla(Params prm, int l) { extern __shared__ __attribute__((aligned(16))) unsigned char lds_raw[]; (void)prm; phase_gla_sample((LAS unsigned char*)lds_raw, l); }
__global__ void __launch_bounds__(NTHREADS, 2) k_attn(Params prm, int j) { extern __shared__ __attribute__((aligned(16))) unsigned char lds_raw[]; (void)prm; phase_attn_simple((LAS unsigned char*)lds_raw, j); }
#endif
__global__ void __launch_bounds__(NTHREADS, 2) fwd(Params prm) {
    extern __shared__ __attribute__((aligned(16))) unsigned char lds_raw[];
    LAS unsigned char* lds = (LAS unsigned char*)lds_raw;
    for (int u = threadIdx.x; u < (LDS_BYTES - LDSCTL_OFF) / 4; u += NTHREADS) ((LAS unsigned*)(lds + LDSCTL_OFF))[u] = 0u;
    __syncthreads();
    XcdBarrier bar; bar.bar = (unsigned*)(prm.ws + WS_CTL) + CW_BAR; bar.x = 0; bar.st = nullptr;
    bar = xcd_barrier_post((unsigned*)(prm.ws + WS_CTL) + CW_BAR, (volatile LAS unsigned*)(lds + MISC_OFF) + 8);
#define PH_BEGIN {
#define PH_END   { XcdBarrier b2; b2.bar = (unsigned*)(get_args().ws() + WS_CTL) + CW_BAR; b2.x = bar.x; asm volatile("" : "+s"(b2.x)); b2.st = bar.st; xcd_barrier(b2); } }
    PH_BEGIN if (SEL(1)) phase_prologue(lds); PH_END
    for (int l = 0; l < 4; ++l) {
        if (l < 2) {
            PH_BEGIN if (SEL(6)) { gphase_hproj(lds, l); conv_drain(lds, 1, l == 0 ? CQ_H0 : (1 << 30), 2, l == 0 ? 0 : CQ_H1); } PH_END
            PH_BEGIN if (SEL(3)) { phase_gla_pre(lds, l); asm volatile("s_waitcnt vmcnt(0)" ::: "memory"); __builtin_amdgcn_fence(__ATOMIC_RELEASE, "workgroup"); __syncthreads(); __builtin_amdgcn_fence(__ATOMIC_ACQUIRE, "workgroup");
                gla_seq<false>(lds, l); phase_gla_sample(lds, l); } PH_END
            PH_BEGIN if (SEL(12)) gla_seq<true>(lds, l); PH_END
        } else {
            PH_BEGIN if (SEL(7)) { gphase_qkv(lds, l - 2); if (l == 2) conv_drain(lds, 2, 1 << 30, 3, CQ_Q0); } PH_END
            PH_BEGIN if (SEL(4)) phase_post(lds, l - 2); PH_END
            PH_BEGIN if (SEL(5)) { phase_attn_prompt(lds, l - 2); phase_attn_simple(lds, l - 2); } PH_END
        }
        PH_BEGIN if (SEL(8)) gphase_wo(lds, l); PH_END
        PH_BEGIN if (SEL(9)) { gphase_ffn1(lds, l); conv_drain(lds, l < 3 ? l + 1 : 3, l == 0 ? CQ_F0 : (l == 1 ? CQ_F1 : (l == 2 ? CQ_F2 : (1 << 30))), 0, 0); } PH_END
        PH_BEGIN if (SEL(10)) gphase_ffn2(lds, l); PH_END
    }
    { if (SEL(13)) phase_fix_sample(lds, 22); }
#undef PH_BEGIN
#undef PH_END
}

extern "C" void kernel_launch(void* const* d_in, const int* in_sizes, int n_in, void* d_out, int out_size, void* d_ws, size_t ws_size, hipStream_t stream) {
    static int ready = 0;
    if (ready == 0) {
        if (n_in != 26 || (size_t)out_size != O_END || ws_size < WS_END) { fprintf(stderr, "kernel_launch: unexpected shapes (n_in %d, out %d, ws %zu; need ws >= %zu)\n", n_in, out_size, ws_size, (size_t)WS_END); ready = -1; return; }
#if V1_SPLIT
        (void)hipFuncSetAttribute((const void*)k_gla, hipFuncAttributeMaxDynamicSharedMemorySize, LDS_BYTES); (void)hipFuncSetAttribute((const void*)k_attn, hipFuncAttributeMaxDynamicSharedMemorySize, LDS_BYTES);
#endif
        if (hipFuncSetAttribute((const void*)fwd, hipFuncAttributeMaxDynamicSharedMemorySize, LDS_BYTES) != hipSuccess) { fprintf(stderr, "kernel_launch: hipFuncSetAttribute failed\n"); ready = -1; return; }
        ready = 1;
    }
    if (ready < 0) return;
    (void)in_sizes;
    if (hipMemsetAsync((char*)d_ws + WS_CTL, 0, CTL_ZERO_BYTES, stream) != hipSuccess) return;
    Params p{};
    for (int i = 0; i < 26; ++i) p.in[i] = (const float*)d_in[i];
    p.out = (float*)d_out; p.ws = (unsigned char*)d_ws;
#if V1_SPLIT
    for (int ph = 0; ph < N_PHASES; ++ph) { p.lo = ph; p.hi = ph + 1;
        if (ph == 3 || ph == 10) { hipLaunchKernelGGL(k_gla, dim3(256), dim3(NTHREADS), LDS_BYTES, stream, p, ph == 3 ? 0 : 1); continue; }
        if (ph == 18 || ph == 26) { hipLaunchKernelGGL(k_attn, dim3(256), dim3(NTHREADS), LDS_BYTES, stream, p, ph == 18 ? 0 : 1); continue; }
        hipLaunchKernelGGL(fwd, dim3(256), dim3(NTHREADS), LDS_BYTES, stream, p); }
#else
    p.lo = 0; p.hi = N_PHASES;
    hipLaunchKernelGGL(fwd, dim3(256), dim3(NTHREADS), LDS_BYTES, stream, p);
#endif
}
```
